# Optimizing an MI355X kernel written in HIP

```python
import math
import jax, jax.numpy as jnp
from jax import lax
import numpy as np

D_MODEL = 1024
BATCH = 8
SEQ = 4096
DEPTH = 4

HEAD_DIM = 64
N_HEADS = D_MODEL // HEAD_DIM
N_MIXERS = 3
DILATED_GROUPS = ((128, 1), (512, 4), (2048, 16))
N_DIL = len(DILATED_GROUPS)
GRID_W = 64
NA_ROWS = 8
NA_COLS = 16
SWA_RADIUS = 128
N_KV_HEADS = 4
GQA_GROUP = N_HEADS // N_KV_HEADS
D_FF = 256 * math.ceil(8 * D_MODEL / (3 * 256))
T5_BUCKETS = 32
T5_MAX_DISTANCE = 1024
N_A = (DEPTH + 2) // 3
N_B = (DEPTH + 1) // 3
N_C = DEPTH // 3
EPS = 1e-6
NEG_INF = -1e30

kernel_name = "hybrid_dilated_neighbourhood_swa_encoder"


def rmsnorm(x, g):
    xf = x.astype(jnp.float32)
    y = xf * lax.rsqrt(jnp.mean(xf * xf, axis=-1, keepdims=True) + EPS)
    return (y * g.astype(jnp.float32)).astype(x.dtype)


def t5_bucket(rel):
    half = T5_BUCKETS // 2
    max_exact = half // 2
    ret = jnp.where(rel > 0, half, 0)
    n = jnp.abs(rel)
    nf = jnp.maximum(n, 1).astype(jnp.float32)
    large = max_exact + (jnp.log(nf / max_exact) / math.log(T5_MAX_DISTANCE / max_exact)
                         * (half - max_exact)).astype(jnp.int32)
    large = jnp.minimum(large, half - 1)
    return ret + jnp.where(n < max_exact, n, large)


def t5_bias(table, rel):
    return jnp.moveaxis(table[t5_bucket(rel)], -1, 0)


def banded_attention(q, k, v, bias, sink):
    Q = bias.shape[-2]
    L = q.shape[0]
    nb = -(-L // Q)
    Lp = nb * Q
    pad = Lp - L
    scale = 1.0 / math.sqrt(q.shape[-1])
    qb = jnp.pad(q, ((0, pad),) + ((0, 0),) * (q.ndim - 1)).reshape(nb, Q, *q.shape[1:])

    def band(t):
        tp = jnp.pad(t, ((Q, pad + Q), (0, 0), (0, 0))).reshape(nb + 2, Q, *t.shape[1:])
        return jnp.concatenate([tp[:-2], tp[1:-1], tp[2:]], axis=1)

    kb, vb = band(k), band(v)
    kp = jnp.arange(-Q, Lp + Q).reshape(nb + 2, Q)
    key_pos = jnp.concatenate([kp[:-2], kp[1:-1], kp[2:]], axis=1)
    rel = jnp.arange(3 * Q)[None, :] - Q - jnp.arange(Q)[:, None]
    mask = (jnp.abs(rel) <= Q)[None] & ((key_pos >= 0) & (key_pos < L))[:, None, :]
    s = jnp.einsum('nqhgd,nkhd->nhgqk', qb, kb).astype(jnp.float32) * scale \
        + bias[None].astype(jnp.float32)
    s = jnp.where(mask[:, None, None], s, NEG_INF)
    lse = jax.nn.logsumexp(s, axis=-1)
    if sink is not None:
        lse = jnp.logaddexp(lse, sink.astype(jnp.float32)[None, :, :, None])
    p = jnp.exp(s - lse[..., None]).astype(v.dtype)
    o = jnp.einsum('nhgqk,nkhd->nqhgd', p, vb).reshape(Lp, *q.shape[1:])[:L]
    lse = lse.transpose(0, 3, 1, 2).reshape(Lp, q.shape[1], q.shape[2])[:L]
    return o, lse


def dilated_mixer(h, w_in, w_out, rel_bias):
    B_, S_, _ = h.shape
    qkv = (h @ w_in).reshape(B_, S_, N_DIL, 3, N_HEADS, HEAD_DIM)
    outs, lses = [], []
    for g, (window, d) in enumerate(DILATED_GROUPS):
        radius = window // (2 * d)
        L = S_ // d

        def by_residue(t):
            return t.reshape(B_, L, d, N_HEADS, HEAD_DIM).transpose(0, 2, 1, 3, 4) \
                    .reshape(B_ * d, L, N_HEADS, HEAD_DIM)

        q = by_residue(qkv[:, :, g, 0])[:, :, :, None]
        k = by_residue(qkv[:, :, g, 1])
        v = by_residue(qkv[:, :, g, 2])
        rel = (jnp.arange(3 * radius)[None, :] - radius - jnp.arange(radius)[:, None]) * d
        bias = t5_bias(rel_bias, rel)[:, None]
        o, lse = lax.map(lambda t: banded_attention(t[0], t[1], t[2], bias, None), (q, k, v))
        outs.append(o.reshape(B_, d, L, N_HEADS, HEAD_DIM).transpose(0, 2, 1, 3, 4)
                    .reshape(B_, S_, N_HEADS, HEAD_DIM))
        lses.append(lse.reshape(B_, d, L, N_HEADS).transpose(0, 2, 1, 3).reshape(B_, S_, N_HEADS))
    w = jax.nn.softmax(jnp.stack(lses), axis=0)
    o = jnp.einsum('gbsh,gbshd->bshd', w.astype(h.dtype), jnp.stack(outs))
    return o.reshape(B_, S_, D_MODEL) @ w_out


def neighbourhood_mixer(h, w_in, w_out, rpb):
    B_, S_, _ = h.shape
    rows = S_ // GRID_W
    kr = min(NA_ROWS, rows)
    kc = NA_COLS
    scale = 1.0 / math.sqrt(HEAD_DIM)
    qkv = (h @ w_in).reshape(B_, rows, GRID_W, 3, N_HEADS, HEAD_DIM)
    qg, kg, vg = qkv[:, :, :, 0], qkv[:, :, :, 1], qkv[:, :, :, 2]
    cols = jnp.arange(GRID_W)
    col_idx = jnp.clip(cols - kc // 2, 0, GRID_W - kc)[:, None] + jnp.arange(kc)[None, :]
    col_off = col_idx - cols[:, None] + (NA_COLS - 1)

    def row_fn(r):
        rs = jnp.clip(r - kr // 2, 0, rows - kr)
        ks = lax.dynamic_slice_in_dim(kg, rs, kr, axis=1)[:, :, col_idx]
        vs = lax.dynamic_slice_in_dim(vg, rs, kr, axis=1)[:, :, col_idx]
        qr = lax.dynamic_index_in_dim(qg, r, axis=1, keepdims=False)
        s = jnp.einsum('bqhd,brqkhd->bhqrk', qr, ks).astype(jnp.float32) * scale
        row_off = rs + jnp.arange(kr) - r + (NA_ROWS - 1)
        bias = rpb[:, row_off][:, :, col_off].transpose(0, 2, 1, 3)
        s = s + bias[None].astype(jnp.float32)
        p = jax.nn.softmax(s.reshape(B_, N_HEADS, GRID_W, kr * kc), axis=-1)
        p = p.reshape(B_, N_HEADS, GRID_W, kr, kc).astype(h.dtype)
        return jnp.einsum('bhqrk,brqkhd->bqhd', p, vs)

    o = lax.map(row_fn, jnp.arange(rows))
    o = o.transpose(1, 0, 2, 3, 4).reshape(B_, S_, D_MODEL)
    return o @ w_out


def window_gqa_mixer(h, w_in, w_out, sink, rel_bias):
    B_, S_, _ = h.shape
    qkv = h @ w_in
    nq, nk = N_HEADS * HEAD_DIM, N_KV_HEADS * HEAD_DIM
    q = qkv[..., :nq].reshape(B_, S_, N_KV_HEADS, GQA_GROUP, HEAD_DIM)
    k = qkv[..., nq:nq + nk].reshape(B_, S_, N_KV_HEADS, HEAD_DIM)
    v = qkv[..., nq + nk:].reshape(B_, S_, N_KV_HEADS, HEAD_DIM)
    R = SWA_RADIUS
    rel = jnp.arange(3 * R)[None, :] - R - jnp.arange(R)[:, None]
    bias = t5_bias(rel_bias, rel).reshape(N_KV_HEADS, GQA_GROUP, R, 3 * R)
    sk = sink.reshape(N_KV_HEADS, GQA_GROUP)
    o, _ = lax.map(lambda t: banded_attention(t[0], t[1], t[2], bias, sk), (q, k, v))
    return o.reshape(B_, S_, D_MODEL) @ w_out


def swiglu(h, w_in, w_out):
    gu = h @ w_in
    gate, up = gu[..., :D_FF], gu[..., D_FF:]
    return (jax.nn.silu(gate) * up) @ w_out


def setup_inputs(seed: int = 0) -> dict:
    key = jax.random.key(seed)
    ks = jax.random.split(key, 20)
    D = D_MODEL
    nrm = jax.random.normal
    f32 = jnp.float32
    return {
        "x": nrm(ks[0], (BATCH, SEQ, D), f32),
        "c": nrm(ks[1], (BATCH, D), f32),
        "rel_bias": 0.5 * nrm(ks[2], (T5_BUCKETS, N_HEADS), f32),
        "ada_w": 0.5 * D ** -0.5 * nrm(ks[3], (DEPTH, D, 6 * D), f32),
        "ada_b": 0.01 * nrm(ks[4], (DEPTH, 6 * D), f32),
        "norm_mix": 1.0 + 0.01 * nrm(ks[5], (DEPTH, D), f32),
        "norm_ffn": 1.0 + 0.01 * nrm(ks[6], (DEPTH, D), f32),
        "norm_final": 1.0 + 0.01 * nrm(ks[7], (D,), f32),
        "a_w_in": D ** -0.5 * nrm(ks[8], (N_A, D, N_DIL * 3 * N_HEADS * HEAD_DIM), f32),
        "a_w_out": D ** -0.5 * nrm(ks[9], (N_A, D, D), f32),
        "b_w_in": D ** -0.5 * nrm(ks[10], (N_B, D, 3 * D), f32),
        "b_w_out": D ** -0.5 * nrm(ks[11], (N_B, D, D), f32),
        "b_rpb": 0.5 * nrm(ks[12], (N_B, N_HEADS, 2 * NA_ROWS - 1, 2 * NA_COLS - 1), f32),
        "c_w_in": D ** -0.5 * nrm(ks[13], (N_C, D, (N_HEADS + 2 * N_KV_HEADS) * HEAD_DIM), f32),
        "c_w_out": D ** -0.5 * nrm(ks[14], (N_C, D, D), f32),
        "c_sink": 0.5 * nrm(ks[15], (N_C, N_HEADS), f32),
        "ffn_w_in": D ** -0.5 * nrm(ks[16], (DEPTH, D, 2 * D_FF), f32),
        "ffn_w_out": D_FF ** -0.5 * nrm(ks[17], (DEPTH, D_FF, D), f32),
    }


def reference(x, c, rel_bias, ada_w, ada_b, norm_mix, norm_ffn, norm_final,
              a_w_in, a_w_out, b_w_in, b_w_out, b_rpb,
              c_w_in, c_w_out, c_sink, ffn_w_in, ffn_w_out):
    cond = jax.nn.silu(c)
    for i in range(DEPTH):
        mod = (cond @ ada_w[i] + ada_b[i])[:, None, :]
        shift1, scale1, gate1, shift2, scale2, gate2 = jnp.split(mod, 6, axis=-1)
        h = rmsnorm(x, norm_mix[i]) * (1 + scale1) + shift1
        kind, j = i % N_MIXERS, i // N_MIXERS
        if kind == 0:
            m = dilated_mixer(h, a_w_in[j], a_w_out[j], rel_bias)
        elif kind == 1:
            m = neighbourhood_mixer(h, b_w_in[j], b_w_out[j], b_rpb[j])
        else:
            m = window_gqa_mixer(h, c_w_in[j], c_w_out[j], c_sink[j], rel_bias)
        x = x + gate1 * m
        h = rmsnorm(x, norm_ffn[i]) * (1 + scale2) + shift2
        x = x + gate2 * swiglu(h, ffn_w_in[i], ffn_w_out[i])
    return rmsnorm(x, norm_final)
```

```cpp
#include <hip/hip_runtime.h>
#include <hip/hip_cooperative_groups.h>
#include <cstdio>
#include <cstdint>
#include <cmath>
namespace cg = cooperative_groups;
namespace pg8 {
#define PG8_LAS __attribute__((address_space(3)))
typedef unsigned short bf16_t;
typedef short bf16x8 __attribute__((ext_vector_type(8)));
typedef float f32x4 __attribute__((ext_vector_type(4)));
typedef unsigned u32x4 __attribute__((ext_vector_type(4)));
constexpr int BM = 256, BK = 64, HALF = 128, HTB = HALF * BK * 2  , STAGE_BYTES = 8 * HTB, NXCD = 8, WGM = 8;

__host__ __device__ __forceinline__ int lds_byte(int r, int c) { const int st = (r >> 4) * 2 + (c >> 5), rr = r & 15, cc = c & 31, ob = rr * 64 + cc * 2; return st * 1024 + (ob ^ (((ob >> 9) & 1) << 5)); }
__host__ __device__ __forceinline__ void stage_rc(int b, int& R, int& C) { const int st = b / 1024, sb = b % 1024, swz = sb ^ (((sb >> 9) & 1) << 5); R = (st >> 1) * 16 + swz / 64; C = (st & 1) * 32 + (swz % 64) / 2; }
__host__ __device__ __forceinline__ int perm32(int rho) { const int n = rho >> 4, i = rho & 15; return 8 * (i >> 2) + 4 * n + (i & 3); }

struct Unit { int pm, pn; };
struct Gemm { const bf16_t* A; const bf16_t* Bt; int M, N, K; };

struct StaticOrder {
    int nM, nN, nwg, G, c;
    __host__ __device__ void init(int M, int N, int G_, int c_) { nM = M / BM; nN = N / BM; nwg = nM * nN; G = G_; c = c_; }
    __host__ __device__ bool next(int i, Unit& u) const {
        const long L = (long)i * G + c; if (L >= nwg) return false;
        int wgid = (int)L; { const int q = nwg / NXCD, r = nwg % NXCD, xcd = wgid % NXCD, off = wgid / NXCD; wgid = (xcd < r ? xcd * (q + 1) : r * (q + 1) + (xcd - r) * q) + off; }
        const int nig = WGM * nN, gid = wgid / nig, fm = gid * WGM, gsz = (nM - fm) < WGM ? (nM - fm) : WGM;
        u.pm = fm + ((wgid % nig) % gsz); u.pn = (wgid % nig) / gsz; return true;
    }
    __device__ __forceinline__ void a_ready(const Unit&) const {}
    __device__ __forceinline__ void done(const Unit&) const {}
};

__device__ __forceinline__ unsigned cvt_pk_bf16(float lo, float hi) { unsigned r; asm volatile("v_cvt_pk_bf16_f32 %0, %1, %2" : "=v"(r) : "v"(lo), "v"(hi)); return r; }
typedef float f32x2 __attribute__((ext_vector_type(2)));
constexpr int BIAS_LD = 9216;
typedef unsigned u32x2 __attribute__((ext_vector_type(2)));
struct EpiStoreBf16 {
    static constexpr bool PERM = true, AFTER_DRAIN = false;
    bf16_t* O; int ldc; const float* ss; const float* bias; int roff;
    __device__ __forceinline__ void operator()(const f32x4 (&acc)[2][2][4][2], const Unit& u, int wr, int wc, int fr, int fq) const {
        const int row0 = u.pm * BM + wr * 64 + fr; const int col0 = u.pn * BM + wc * 32 + 8 * fq;
        const float* bp = bias + (size_t)((roff + u.pm * BM) >> 12) * BIAS_LD + col0;
        f32x4 bv[2][2];
#pragma unroll
        for (int bj = 0; bj < 2; ++bj)
#pragma unroll
            for (int n = 0; n < 2; ++n) bv[bj][n] = *(const f32x4*)(bp + bj * HALF + 4 * n);
        float rsv[2][4];
#pragma unroll
        for (int ai = 0; ai < 2; ++ai)
#pragma unroll
            for (int m = 0; m < 4; ++m) rsv[ai][m] = ss[roff + row0 + ai * HALF + m * 16];
#pragma unroll
        for (int ai = 0; ai < 2; ++ai)
#pragma unroll
            for (int m = 0; m < 4; ++m) { const int r = row0 + ai * HALF + m * 16; bf16_t* rowp = O + (size_t)r * ldc + col0;
                const float rs = __builtin_amdgcn_rsqf(rsv[ai][m] * (1.0f / 1024.0f) + 1e-6f);
#pragma unroll
                for (int bj = 0; bj < 2; ++bj) { const f32x4 v0 = acc[ai][bj][m][0] * rs + bv[bj][0], v1 = acc[ai][bj][m][1] * rs + bv[bj][1];
                    u32x4 w; w.x = cvt_pk_bf16(v0[0], v0[1]); w.y = cvt_pk_bf16(v0[2], v0[3]); w.z = cvt_pk_bf16(v1[0], v1[1]); w.w = cvt_pk_bf16(v1[2], v1[3]);
                    *(u32x4*)(rowp + bj * HALF) = w; } }
    }
};
__device__ __forceinline__ float silu_f(float x) { return x * __builtin_amdgcn_rcpf(1.0f + __builtin_amdgcn_exp2f(-1.44269504089f * x)); }
struct EpiSwiglu {
    static constexpr bool PERM = true, AFTER_DRAIN = false;
    bf16_t* H; int ldh; const float* ss; const float* bias;
    __device__ __forceinline__ void operator()(const f32x4 (&acc)[2][2][4][2], const Unit& u, int wr, int wc, int fr, int fq) const {
        const int row0 = u.pm * BM + wr * 64 + fr; const int col0 = u.pn * HALF + wc * 32 + 8 * fq;
        const float* bp = bias + (size_t)((u.pm * BM) >> 12) * BIAS_LD + u.pn * BM + wc * 32 + 8 * fq;
        f32x4 bv[2][2];
#pragma unroll
        for (int bj = 0; bj < 2; ++bj)
#pragma unroll
            for (int n = 0; n < 2; ++n) bv[bj][n] = *(const f32x4*)(bp + bj * HALF + 4 * n);
        float rsv[2][4];
#pragma unroll
        for (int ai = 0; ai < 2; ++ai)
#pragma unroll
            for (int m = 0; m < 4; ++m) rsv[ai][m] = ss[row0 + ai * HALF + m * 16];
#pragma unroll
        for (int ai = 0; ai < 2; ++ai)
#pragma unroll
            for (int m = 0; m < 4; ++m) { const int r = row0 + ai * HALF + m * 16; bf16_t* rowp = H + (size_t)r * ldh + col0;
                const float rs = __builtin_amdgcn_rsqf(rsv[ai][m] * (1.0f / 1024.0f) + 1e-6f);
                const f32x4 g0 = acc[ai][0][m][0] * rs + bv[0][0], g1 = acc[ai][0][m][1] * rs + bv[0][1], u0 = acc[ai][1][m][0] * rs + bv[1][0], u1 = acc[ai][1][m][1] * rs + bv[1][1];
                u32x4 w; w.x = cvt_pk_bf16(silu_f(g0[0]) * u0[0], silu_f(g0[1]) * u0[1]); w.y = cvt_pk_bf16(silu_f(g0[2]) * u0[2], silu_f(g0[3]) * u0[3]);
                w.z = cvt_pk_bf16(silu_f(g1[0]) * u1[0], silu_f(g1[1]) * u1[1]); w.w = cvt_pk_bf16(silu_f(g1[2]) * u1[2], silu_f(g1[3]) * u1[3]);
                *(u32x4*)rowp = w; }
    }
};
struct EpiResid {
    static constexpr bool PERM = false, AFTER_DRAIN = false;
    const float* xin; float* xout; const float* gate; const float* wv; bf16_t* xn; float* ssn;
    __device__ __forceinline__ void operator()(const f32x4 (&acc)[2][2][4][2], const Unit& u, int wr, int wc, int fr, int fq) const {
        const int col0 = u.pn * BM + wc * 32 + 4 * fq; const int b = (u.pm * BM) >> 12;
        f32x4 gv[2][2], wvv[2][2];
#pragma unroll
        for (int bj = 0; bj < 2; ++bj)
#pragma unroll
            for (int n = 0; n < 2; ++n) { gv[bj][n] = *(const f32x4*)(gate + (size_t)b * 6144 + col0 + bj * HALF + n * 16); wvv[bj][n] = *(const f32x4*)(wv + (size_t)b * 1024 + col0 + bj * HALF + n * 16); }
        f32x4 xb[2][2][2];
        { const size_t off0 = (size_t)(u.pm * BM + wr * 64 + fr) * 1024 + col0;
#pragma unroll
          for (int bj = 0; bj < 2; ++bj)
#pragma unroll
            for (int n = 0; n < 2; ++n) xb[0][bj][n] = *(const f32x4*)(xin + off0 + bj * HALF + n * 16); }
#pragma unroll
        for (int rg = 0; rg < 8; ++rg) { const int ai = rg >> 2, m = rg & 3; const int row = u.pm * BM + ai * HALF + wr * 64 + m * 16 + fr; const size_t off = (size_t)row * 1024 + col0; float sp = 0.f;
            if (rg < 7) { const int ai2 = (rg + 1) >> 2, m2 = (rg + 1) & 3; const size_t off2 = (size_t)(u.pm * BM + ai2 * HALF + wr * 64 + m2 * 16 + fr) * 1024 + col0;
#pragma unroll
                for (int bj = 0; bj < 2; ++bj)
#pragma unroll
                    for (int n = 0; n < 2; ++n) xb[(rg + 1) & 1][bj][n] = *(const f32x4*)(xin + off2 + bj * HALF + n * 16); }
#pragma unroll
            for (int bj = 0; bj < 2; ++bj) { u32x2 wq[2];
#pragma unroll
                for (int n = 0; n < 2; ++n) { const f32x4 x1 = xb[rg & 1][bj][n] + gv[bj][n] * acc[ai][bj][m][n];
                    *(f32x4*)(xout + off + bj * HALF + n * 16) = x1; sp += (x1[0] * x1[0] + x1[1] * x1[1]) + (x1[2] * x1[2] + x1[3] * x1[3]);
                    const f32x4 y = x1 * wvv[bj][n]; wq[n].x = cvt_pk_bf16(y[0], y[1]); wq[n].y = cvt_pk_bf16(y[2], y[3]); }
                if (xn) {
                    const bool odd = (fq & 1) != 0; const u32x2 snd = odd ? wq[0] : wq[1]; u32x2 rcv; rcv.x = __shfl_xor(snd.x, 16); rcv.y = __shfl_xor(snd.y, 16);
                    u32x4 o; if (odd) { o.x = rcv.x; o.y = rcv.y; o.z = wq[1].x; o.w = wq[1].y; } else { o.x = wq[0].x; o.y = wq[0].y; o.z = rcv.x; o.w = rcv.y; }
                    *(u32x4*)(xn + off + bj * HALF + (odd ? 12 : 0)) = o; } }
            sp += __shfl_xor(sp, 16); sp += __shfl_xor(sp, 32);
            if (fq == 0) __hip_atomic_fetch_add(ssn + row, sp, __ATOMIC_RELAXED, __HIP_MEMORY_SCOPE_AGENT); }
    }
};
template <class Epi, class Sched, bool ALIGN_EPI = false, bool SP2 = false>
__device__ __forceinline__ void gemm_phase(PG8_LAS unsigned char* lds, const Gemm g, const Sched& S, const Epi& E) {
    int tid = threadIdx.x; asm volatile("" : "+v"(tid));
    const int wid = __builtin_amdgcn_readfirstlane(tid >> 6), lane = tid & 63, wr = wid >> 2, wc = wid & 3, fr = lane & 15, fq = lane >> 4;
    const int K = g.K, nt = K / BK;
    unsigned voffA[2], voffB[2];
#pragma unroll
    for (int i = 0; i < 2; ++i) { int R, C; stage_rc(tid * 16 + i * 8192, R, C); const int Rb = Epi::PERM ? ((R & ~31) + perm32(R & 31)) : R;
        voffA[i] = (unsigned)(R * K + C) * 2u; voffB[i] = (unsigned)(Rb * K + C) * 2u; }
    const size_t kstep = (size_t)(BK * 2);
    const size_t hstep = (size_t)HALF * K * 2;
    const size_t tstep = 2 * hstep;
    const unsigned ldsw = (unsigned)wid * 1024u;
    const int aoff = lds_byte(wr * 64 + fr, fq * 8), boff = lds_byte(wc * 32 + fr, fq * 8);
#define PG8_SA(b, h) (((b) * 2 + (h)) * HTB)
#define PG8_SB(b, h) ((4 + (b) * 2 + (h)) * HTB)
#define PG8_STAGE(bufoff, gbase, voff) do { _Pragma("unroll") for (int _i = 0; _i < 2; ++_i) \
        __builtin_amdgcn_global_load_lds((const unsigned*)((const char*)(gbase) + (voff)[_i]), (PG8_LAS unsigned*)(lds + (bufoff) + ldsw + _i * 8192), 16, 0, 0); } while (0)
#define PG8_LDA(dst, b, h) do { _Pragma("unroll") for (int m = 0; m < 4; ++m) _Pragma("unroll") for (int k = 0; k < 2; ++k) dst[m][k] = *(const PG8_LAS bf16x8*)(lds + PG8_SA(b, h) + aoff + m * 2048 + k * 1024); } while (0)
#define PG8_LDB(dst, b, h) do { _Pragma("unroll") for (int n = 0; n < 2; ++n) _Pragma("unroll") for (int k = 0; k < 2; ++k) dst[n][k] = *(const PG8_LAS bf16x8*)(lds + PG8_SB(b, h) + boff + n * 2048 + k * 1024); } while (0)
#define PG8_MMA(ai, bj, At, Bt) do { __builtin_amdgcn_s_setprio(1); _Pragma("unroll") for (int m = 0; m < 4; ++m) _Pragma("unroll") for (int n = 0; n < 2; ++n) _Pragma("unroll") for (int k = 0; k < 2; ++k) \
        acc[ai][bj][m][n] = __builtin_amdgcn_mfma_f32_16x16x32_bf16(Bt[n][k], At[m][k], acc[ai][bj][m][n], 0, 0, 0); __builtin_amdgcn_s_setprio(0); } while (0)
#define PG8_WAIT_V(n) asm volatile("s_waitcnt vmcnt(" #n ")" ::: "memory")
#define PG8_WAIT_L(n) asm volatile("s_waitcnt lgkmcnt(" #n ")" ::: "memory")
#define PG8_BAR __builtin_amdgcn_s_barrier()
#define PG8_SCHED __builtin_amdgcn_sched_barrier(0)
    Unit cur, nxt; int ui = 0;
    if (!S.next(0, cur)) return;
    f32x4 acc[2][2][4][2];
#pragma unroll
    for (int a = 0; a < 2; ++a)
#pragma unroll
        for (int b = 0; b < 2; ++b)
#pragma unroll
            for (int m = 0; m < 4; ++m)
#pragma unroll
                for (int n = 0; n < 2; ++n) acc[a][b][m][n] = (f32x4){0.f, 0.f, 0.f, 0.f};
    bf16x8 At[4][2], B0[2][2], B1[2][2];
    const char* cA = (const char*)g.A + (size_t)cur.pm * tstep; const char* cB = (const char*)g.Bt + (size_t)cur.pn * tstep;
    S.a_ready(cur);
    if constexpr (SP2) {
        PG8_STAGE(PG8_SB(0, 0), cB, voffB); PG8_STAGE(PG8_SB(0, 1), cB + hstep, voffB); PG8_STAGE(PG8_SA(0, 0), cA, voffA); PG8_STAGE(PG8_SA(0, 1), cA + hstep, voffA);
        if (wr == 1) PG8_BAR;
        PG8_WAIT_V(2); PG8_BAR;
        PG8_STAGE(PG8_SB(1, 0), cB + kstep, voffB); PG8_STAGE(PG8_SA(1, 0), cA + kstep, voffA); PG8_STAGE(PG8_SB(1, 1), cB + hstep + kstep, voffB);
        PG8_WAIT_V(6); PG8_BAR;
    } else {
        PG8_STAGE(PG8_SB(0, 0), cB, voffB); PG8_STAGE(PG8_SA(0, 0), cA, voffA); PG8_STAGE(PG8_SB(0, 1), cB + hstep, voffB); PG8_STAGE(PG8_SA(0, 1), cA + hstep, voffA);
        if (wr == 1) PG8_BAR;
        PG8_WAIT_V(4); PG8_BAR;
        PG8_STAGE(PG8_SB(1, 0), cB + kstep, voffB); PG8_STAGE(PG8_SA(1, 0), cA + kstep, voffA); PG8_STAGE(PG8_SB(1, 1), cB + hstep + kstep, voffB);
        PG8_WAIT_V(6); PG8_BAR;
    }
    for (;;) {
        const bool has_next = S.next(ui + 1, nxt);
        const char* nA = has_next ? (const char*)g.A + (size_t)nxt.pm * tstep : cA; const char* nB = has_next ? (const char*)g.Bt + (size_t)nxt.pn * tstep : cB;
        for (int t = 0; t < nt; t += 2) {
            const bool last = (t == nt - 2);
            const char* a1 = cA + (size_t)(t + 1) * kstep;
            const char* a2 = last ? nA : cA + (size_t)(t + 2) * kstep; const char* b2 = last ? nB : cB + (size_t)(t + 2) * kstep;
            const char* a3 = a2 + kstep; const char* b3 = b2 + kstep;
            if (last && has_next) S.a_ready(nxt);
            if constexpr (SP2) {
            PG8_LDB(B0, 0, 0); PG8_LDB(B1, 0, 1); PG8_SCHED; PG8_LDA(At, 0, 0); PG8_STAGE(PG8_SA(1, 1), a1 + hstep, voffA);
            PG8_WAIT_V(8); PG8_WAIT_L(0); PG8_BAR; PG8_MMA(0, 0, At, B0); PG8_MMA(0, 1, At, B1); PG8_BAR; PG8_SCHED;
            PG8_LDA(At, 0, 1); PG8_STAGE(PG8_SB(0, 0), b2, voffB); PG8_STAGE(PG8_SB(0, 1), b2 + hstep, voffB); PG8_STAGE(PG8_SA(0, 0), a2, voffA);
            PG8_WAIT_V(8); PG8_WAIT_L(0); PG8_BAR; PG8_MMA(1, 0, At, B0); PG8_MMA(1, 1, At, B1); PG8_BAR; PG8_SCHED;
            PG8_LDB(B0, 1, 0); PG8_LDB(B1, 1, 1); PG8_SCHED; PG8_LDA(At, 1, 0); PG8_STAGE(PG8_SA(0, 1), a2 + hstep, voffA);
            PG8_WAIT_V(8); PG8_WAIT_L(0); PG8_BAR; PG8_MMA(0, 0, At, B0); PG8_MMA(0, 1, At, B1); PG8_BAR; PG8_SCHED;
            PG8_LDA(At, 1, 1); PG8_STAGE(PG8_SB(1, 0), b3, voffB); PG8_STAGE(PG8_SB(1, 1), b3 + hstep, voffB); PG8_STAGE(PG8_SA(1, 0), a3, voffA);
            PG8_WAIT_V(8); PG8_WAIT_L(0); PG8_BAR; PG8_MMA(1, 0, At, B0); PG8_MMA(1, 1, At, B1); PG8_BAR; PG8_SCHED;
            } else {
            PG8_LDB(B0, 0, 0); PG8_SCHED; PG8_LDA(At, 0, 0); PG8_STAGE(PG8_SA(1, 1), a1 + hstep, voffA);
            PG8_WAIT_L(8); PG8_BAR; PG8_WAIT_L(0); PG8_MMA(0, 0, At, B0); PG8_BAR; PG8_SCHED;
            PG8_LDB(B1, 0, 1); PG8_STAGE(PG8_SB(0, 0), b2, voffB);
            PG8_BAR; PG8_WAIT_L(0); PG8_MMA(0, 1, At, B1); PG8_BAR;
            PG8_LDA(At, 0, 1); PG8_STAGE(PG8_SA(0, 0), a2, voffA);
            PG8_BAR; PG8_WAIT_L(0); PG8_MMA(1, 0, At, B0); PG8_BAR; PG8_SCHED;
            PG8_STAGE(PG8_SB(0, 1), b2 + hstep, voffB);
            PG8_WAIT_V(6); PG8_BAR; PG8_MMA(1, 1, At, B1); PG8_BAR;
            PG8_LDB(B0, 1, 0); PG8_SCHED; PG8_LDA(At, 1, 0); PG8_STAGE(PG8_SA(0, 1), a2 + hstep, voffA);
            PG8_WAIT_L(8); PG8_BAR; PG8_WAIT_L(0); PG8_MMA(0, 0, At, B0); PG8_BAR; PG8_SCHED;
            PG8_LDB(B1, 1, 1); PG8_STAGE(PG8_SB(1, 0), b3, voffB);
            PG8_BAR; PG8_WAIT_L(0); PG8_MMA(0, 1, At, B1); PG8_BAR;
            PG8_LDA(At, 1, 1); PG8_STAGE(PG8_SA(1, 0), a3, voffA);
            PG8_BAR; PG8_WAIT_L(0); PG8_MMA(1, 0, At, B0); PG8_BAR; PG8_SCHED;
            PG8_STAGE(PG8_SB(1, 1), b3 + hstep, voffB);
            PG8_WAIT_V(6); PG8_BAR; PG8_MMA(1, 1, At, B1); PG8_BAR;
            }
        }
        if constexpr (ALIGN_EPI) { if (wr == 0) PG8_BAR; }
        if constexpr (!Epi::AFTER_DRAIN) { E(acc, cur, wr, wc, fr, fq); S.done(cur); }
        if (!has_next) break;
#pragma unroll
        for (int a = 0; a < 2; ++a)
#pragma unroll
            for (int b = 0; b < 2; ++b)
#pragma unroll
                for (int m = 0; m < 4; ++m)
#pragma unroll
                    for (int n = 0; n < 2; ++n) acc[a][b][m][n] = (f32x4){0.f, 0.f, 0.f, 0.f};
        cur = nxt; cA = nA; cB = nB; ++ui;
        if constexpr (ALIGN_EPI) { if (wr == 1) PG8_BAR; }
    }
    PG8_WAIT_V(0);
    if constexpr (!ALIGN_EPI) { if (wr == 0) PG8_BAR; }
    PG8_BAR;
    if constexpr (Epi::AFTER_DRAIN) { E.fused(acc, cur, wr, wc, fr, fq, lds, wid, lane); S.done(cur); }
#undef PG8_SA
#undef PG8_SB
#undef PG8_STAGE
#undef PG8_LDA
#undef PG8_LDB
#undef PG8_MMA
#undef PG8_WAIT_V
#undef PG8_WAIT_L
#undef PG8_BAR
#undef PG8_SCHED
}
}

#ifndef MK_PER_PHASE_LAUNCH
#define MK_PER_PHASE_LAUNCH 0
#endif
#define LAS __attribute__((address_space(3)))
typedef unsigned short bf16;
typedef unsigned u32x4 __attribute__((ext_vector_type(4)));
typedef unsigned u32x2 __attribute__((ext_vector_type(2)));
typedef float f32x4 __attribute__((ext_vector_type(4)));
typedef short bf16x8 __attribute__((ext_vector_type(8)));
typedef short s16x4 __attribute__((ext_vector_type(4)));
typedef LAS unsigned char* ldsp;
typedef LAS const unsigned char* ldscp;

constexpr int NWAVES = 8, NTHR = 512;
constexpr int DM = 1024, NB = 8, SEQ = 4096, MTOK = NB * SEQ, DFF = 2816, NFF2 = 2 * DFF;
constexpr int NA_IN = 9216, NB_IN = 3072, NC_IN = 1536;
constexpr int NG_IN = 3072;
constexpr size_t MiB = 1u << 20;
constexpr size_t WS_MOD = 1 * MiB;
constexpr size_t WS_LUT = 2 * MiB;
constexpr size_t WS_W = 3 * MiB;
constexpr size_t W_AIN = 0, W_AOUT = W_AIN + 2ull * NA_IN * DM, W_BIN = W_AOUT + 2ull * DM * DM, W_BOUT = W_BIN + (size_t)NB_IN * DM, W_CIN = W_BOUT + (size_t)DM * DM,
                 W_COUT = W_CIN + (size_t)NC_IN * DM, W_F1 = W_COUT + (size_t)DM * DM, W_F2 = W_F1 + 4ull * NFF2 * DM, W_END = W_F2 + 4ull * DM * DFF;
static_assert(W_END * 2 == 119 * MiB, "weights");
constexpr size_t WS_XN = 122 * MiB;
constexpr size_t WS_AO = 186 * MiB;
constexpr size_t WS_BIG = 250 * MiB;
constexpr size_t WS_LSE = 442 * MiB;
constexpr size_t WS_SS = 444 * MiB;
constexpr size_t WS_WV = 446 * MiB;
constexpr size_t WS_BIAS = 447 * MiB;
constexpr size_t WS_END = 450 * MiB;
constexpr int BIAS_LD = pg8::BIAS_LD;
constexpr int LUTA_P = 132, LUTC_P = 260, LUTC_OFF = 3 * 16 * LUTA_P;
constexpr int LDS_BYTES = 163840;
constexpr int KP = 144;
constexpr int LDS_BARST = LDS_BYTES - 64;
constexpr int LDS_K = 0, LDS_V = 512 * KP, LDS_LUT = 2 * 512 * KP;

struct Args { const float* in[18]; float* out; unsigned char* ws; int lo, hi; };
typedef __attribute__((address_space(4))) const volatile unsigned long long* kargp;
#define GAS __attribute__((address_space(1)))
__device__ __forceinline__ const float* KIN(int i) { return (const float*)(GAS const float*)(((kargp)__builtin_amdgcn_kernarg_segment_ptr())[i]); }
__device__ __forceinline__ float* KOUT() { return (float*)(GAS float*)(((kargp)__builtin_amdgcn_kernarg_segment_ptr())[18]); }
__device__ __forceinline__ unsigned char* KWS() { return (unsigned char*)(GAS unsigned char*)(((kargp)__builtin_amdgcn_kernarg_segment_ptr())[19]); }

__device__ __forceinline__ float wave_sum(float v) {
#pragma unroll
    for (int o = 1; o < 64; o <<= 1) v += __shfl_xor(v, o);
    return v;
}
__device__ __forceinline__ unsigned f2bf(float f) { unsigned u = __builtin_bit_cast(unsigned, f); return (u + 0x7fffu + ((u >> 16) & 1u)) >> 16; }
__device__ __forceinline__ unsigned pk2(float lo, float hi) { return f2bf(lo) | (f2bf(hi) << 16); }
__device__ __forceinline__ float bf_lo(unsigned u) { return __builtin_bit_cast(float, u << 16); }
__device__ __forceinline__ float bf_hi(unsigned u) { return __builtin_bit_cast(float, u & 0xffff0000u); }

template <int MODE>
__device__ __forceinline__ void transpose_item(const float* W, int K, int N, bf16* WT, LAS float* scr, int item, int lane) {
    const int nblk = N / 32, kb = item / nblk, nb = item % nblk, k0 = 64 * kb, n0 = 32 * nb;
    int drow0 = n0;
    if (MODE == 1) { const int s = n0 < DFF ? n0 : n0 - DFF; drow0 = (s >> 7) * 256 + (s & 127) + (n0 < DFF ? 0 : 128); }
#pragma unroll 8
    for (int i = 0; i < 32; ++i) { const int kk = 2 * i + (lane >> 5); scr[kk * 33 + (lane & 31)] = W[(size_t)(k0 + kk) * N + n0 + (lane & 31)]; }
    asm volatile("s_waitcnt lgkmcnt(0)" ::: "memory");
    const int c = lane & 7;
#pragma unroll
    for (int j = 0; j < 4; ++j) { const int n = (lane >> 3) + 8 * j; const LAS float* s = scr + (8 * c) * 33 + n;
        u32x4 o; o.x = pk2(s[0 * 33], s[1 * 33]); o.y = pk2(s[2 * 33], s[3 * 33]); o.z = pk2(s[4 * 33], s[5 * 33]); o.w = pk2(s[6 * 33], s[7 * 33]);
        *(u32x4*)(WT + (size_t)(drow0 + n) * K + k0 + 8 * c) = o; }
    asm volatile("s_waitcnt lgkmcnt(0)" ::: "memory");
}
__device__ __forceinline__ int t5_bucket(int rel) {
    const int n = rel < 0 ? -rel : rel; const float nf = (float)(n > 1 ? n : 1);
    const float v = logf(nf * 0.125f) / 4.852030263919617f * 8.0f;
    int large = 8 + (int)v; large = large < 15 ? large : 15;
    return (rel > 0 ? 16 : 0) + (n < 8 ? n : large);
}
__device__ __forceinline__ void prologue(ldsp lds, int tid, int wave, int lane, int G, int bid) {
    bf16* WT = (bf16*)(KWS() + WS_W);
    LAS float* scr = (LAS float*)(lds + wave * 16384);
    const int gw = bid * NWAVES + wave, NGW = G * NWAVES;
    int it = gw;
#define TR(MODE, src, Kk, Nn, dstoff) { const int cnt = ((Kk) / 64) * ((Nn) / 32); for (; it < cnt; it += NGW) transpose_item<MODE>((src), (Kk), (Nn), WT + (dstoff), scr, it, lane); it -= cnt; }
    TR(0, KIN(8), DM, NA_IN, W_AIN)
    TR(0, KIN(8) + (size_t)DM * NA_IN, DM, NA_IN, W_AIN + (size_t)NA_IN * DM)
    TR(0, KIN(9), DM, DM, W_AOUT)
    TR(0, KIN(9) + (size_t)DM * DM, DM, DM, W_AOUT + (size_t)DM * DM)
    TR(0, KIN(10), DM, NB_IN, W_BIN)
    TR(0, KIN(11), DM, DM, W_BOUT)
    TR(0, KIN(13), DM, NC_IN, W_CIN)
    TR(0, KIN(14), DM, DM, W_COUT)
#pragma unroll 1
    for (int l = 0; l < 4; ++l) TR(1, KIN(16) + (size_t)l * DM * NFF2, DM, NFF2, W_F1 + (size_t)l * NFF2 * DM)
#pragma unroll 1
    for (int l = 0; l < 4; ++l) TR(0, KIN(17) + (size_t)l * DFF * DM, DFF, DM, W_F2 + (size_t)l * DM * DFF)
#undef TR
    { float* lut = (float*)(KWS() + WS_LUT); const float* rb = KIN(2); const int gt = bid * NTHR + tid, NT = G * NTHR;
      for (int i = gt; i < 3 * 16 * 129; i += NT) { const int r = i % 129, h = (i / 129) & 15, g = i / (129 * 16); lut[(g * 16 + h) * LUTA_P + r] = rb[t5_bucket((r - 64) * (1 << (2 * g))) * 16 + h]; }
      for (int i = gt; i < 16 * 257; i += NT) { const int r = i % 257, h = i / 257; lut[LUTC_OFF + h * LUTC_P + r] = rb[t5_bucket(r - 128) * 16 + h]; } }
    __syncthreads();
    LAS float* sc = (LAS float*)lds; LAS float* red = (LAS float*)(lds + 32768);
    for (int i = tid; i < NB * DM; i += NTHR) { const float v = KIN(1)[i]; sc[i] = v / (1.0f + __expf(-v)); }
    __syncthreads();
    float* mod = (float*)(KWS() + WS_MOD);
    for (int unit = bid; unit < 4 * 96; unit += G) {
        const int l = unit / 96, cb = unit % 96;
        const float* wp = KIN(3) + (size_t)l * DM * 6144 + (size_t)(wave * 128) * 6144 + cb * 64 + lane;
        float acc[8];
#pragma unroll
        for (int b = 0; b < 8; ++b) acc[b] = 0.f;
#pragma unroll 4
        for (int k = 0; k < 128; ++k) { const float wv = wp[(size_t)k * 6144];
#pragma unroll
            for (int b = 0; b < 8; ++b) acc[b] += sc[b * DM + wave * 128 + k] * wv; }
#pragma unroll
        for (int b = 0; b < 8; ++b) red[(wave * 8 + b) * 64 + lane] = acc[b];
        __syncthreads();
        { const int b = tid >> 6; float s = KIN(4)[l * 6144 + cb * 64 + lane];
#pragma unroll
          for (int w = 0; w < 8; ++w) s += red[(w * 8 + b) * 64 + lane];
          mod[(size_t)(l * 8 + b) * 6144 + cb * 64 + lane] = s; }
        __syncthreads();
    }
}

__device__ __forceinline__ void norm0_phase(int tid, int wave, int lane, int G, int bid) {
    const float* mod = (const float*)(KWS() + WS_MOD);
    const int gw = bid * NWAVES + wave, NGW = G * NWAVES;
    { float* wv = (float*)(KWS() + WS_WV); const int gt = bid * NTHR + tid, NT = G * NTHR;
      for (int i = gt; i < 9 * 8 * 1024; i += NT) { const int k = i & 1023, b = (i >> 10) & 7, idx = i >> 13; float v;
          if (idx == 8) v = KIN(7)[k]; else { const int l = idx >> 1, wh = idx & 1; const float g = (wh ? KIN(6) : KIN(5))[l * 1024 + k]; v = g * (1.0f + mod[(size_t)(l * 8 + b) * 6144 + (wh ? 4096 : 1024) + k]); }
          wv[i] = v; } }
#pragma unroll 1
    for (int gi = 0; gi < 8; ++gi) {
        const int l = gi >> 1, wh = gi & 1, mk = l % 3, mj = l / 3;
        const int N = wh ? NFF2 : (mk == 0 ? NA_IN : (mk == 1 ? NB_IN : NC_IN));
        const bf16* wt = (const bf16*)(KWS() + WS_W) + (wh ? W_F1 + (size_t)l * NFF2 * DM : (mk == 0 ? W_AIN + (size_t)mj * NA_IN * DM : (mk == 1 ? W_BIN : W_CIN)));
        float sh[8][16];
#pragma unroll
        for (int b = 0; b < 8; ++b)
#pragma unroll
            for (int h = 0; h < 2; ++h) { const float* sp = mod + (size_t)(l * 8 + b) * 6144 + (wh ? 3072 : 0) + h * 512 + 8 * lane; const f32x4 a0 = *(const f32x4*)sp, a1 = *(const f32x4*)(sp + 4);
                sh[b][h * 8 + 0] = a0[0]; sh[b][h * 8 + 1] = a0[1]; sh[b][h * 8 + 2] = a0[2]; sh[b][h * 8 + 3] = a0[3]; sh[b][h * 8 + 4] = a1[0]; sh[b][h * 8 + 5] = a1[1]; sh[b][h * 8 + 6] = a1[2]; sh[b][h * 8 + 7] = a1[3]; }
        float* bias = (float*)(KWS() + WS_BIAS) + (size_t)gi * 8 * BIAS_LD;
        for (int n = gw; n < N; n += NGW) {
            const u32x4 w0 = *(const u32x4*)(wt + (size_t)n * DM + 8 * lane), w1 = *(const u32x4*)(wt + (size_t)n * DM + 512 + 8 * lane);
            float wf[16];
#pragma unroll
            for (int j = 0; j < 4; ++j) { wf[2 * j] = bf_lo(w0[j]); wf[2 * j + 1] = bf_hi(w0[j]); wf[8 + 2 * j] = bf_lo(w1[j]); wf[8 + 2 * j + 1] = bf_hi(w1[j]); }
            float mine = 0.f;
#pragma unroll
            for (int b = 0; b < 8; ++b) { float t = 0.f;
#pragma unroll
                for (int j = 0; j < 16; ++j) t += sh[b][j] * wf[j];
                t = wave_sum(t); mine = (lane == b) ? t : mine; }
            if (lane < 8) bias[(size_t)lane * BIAS_LD + n] = mine;
        }
    }
    { const float* x = KIN(0); bf16* xn = (bf16*)(KWS() + WS_XN); float* ss = (float*)(KWS() + WS_SS);
      f32x4 gv[4];
#pragma unroll
      for (int j = 0; j < 4; ++j) gv[j] = *(const f32x4*)(KIN(5) + 4 * (lane + 64 * j));
      for (int m = gw; m < MTOK; m += NGW) {
        const f32x4* xr = (const f32x4*)(x + (size_t)m * DM) + lane;
        f32x4 v[4]; float s = 0.f;
#pragma unroll
        for (int j = 0; j < 4; ++j) { v[j] = xr[64 * j]; s += (v[j].x * v[j].x + v[j].y * v[j].y) + (v[j].z * v[j].z + v[j].w * v[j].w); }
        s = wave_sum(s); if (lane == 0) ss[m] = s;
        const int b = m >> 12; u32x2* o8 = (u32x2*)(xn + (size_t)m * DM) + lane;
#pragma unroll
        for (int j = 0; j < 4; ++j) { const f32x4 scl = *(const f32x4*)(mod + (size_t)b * 6144 + 1024 + 4 * (lane + 64 * j));
            const f32x4 y = v[j] * gv[j] * (scl + 1.0f); u32x2 w; w.x = pk2(y.x, y.y); w.y = pk2(y.z, y.w); o8[64 * j] = w; }
      } }
}
__device__ __forceinline__ void fin_phase(int wave, int lane, int G, int bid) {
    const int gw = bid * NWAVES + wave, NGW = G * NWAVES;
    float* out = KOUT(); const float* ss = (const float*)(KWS() + WS_SS) + (size_t)8 * MTOK;
    f32x4 gv[4];
#pragma unroll
    for (int j = 0; j < 4; ++j) gv[j] = *(const f32x4*)(KIN(7) + 4 * (lane + 64 * j));
    for (int m = gw; m < MTOK; m += NGW) {
        f32x4* xr = (f32x4*)(out + (size_t)m * DM) + lane; const float rstd = 1.0f / sqrtf(ss[m] * (1.0f / DM) + 1e-6f);
#pragma unroll
        for (int j = 0; j < 4; ++j) xr[64 * j] = (xr[64 * j] * rstd) * gv[j];
    }
}

__device__ __forceinline__ s16x4 vtr(ldscp p) { return __builtin_bit_cast(s16x4, __builtin_amdgcn_ds_read_tr16_b64_v4i16((LAS s16x4*)p)); }
__device__ __forceinline__ unsigned cvtpk(float lo, float hi) { unsigned r; asm volatile("v_cvt_pk_bf16_f32 %0, %1, %2" : "=v"(r) : "v"(lo), "v"(hi)); return r; }

template <int KIND, int NCH, int VP = KP>
__device__ __forceinline__ void attn_wave(ldscp Ks, ldscp Vs, const LAS float* lut, const LAS float* pen, bf16x8 q0, bf16x8 q1, int krow0, int p0, int p1, int p2, int p3, float sinkv,
                                          f32x4 (&O)[4], float& mo, float& lo, int lane) {
    constexpr int RS = (KIND == 1) ? 64 : 32;
    const int i16 = lane & 15, G = lane >> 4;
    f32x4 S[NCH][2];
    const int slot0 = (KIND == 1) ? (int)sinkv : (KIND == 2 ? p1 : 0);
#define ATT_ROWOFF(ch) ((KIND != 0) ? ((slot0 + (ch) >= 9 ? slot0 + (ch) - 9 : slot0 + (ch)) * RS) : RS * (ch))
    { ldscp kp = Ks + (krow0 + 8 * (i16 >> 2) + (i16 & 3)) * KP + 16 * G;
#pragma unroll
      for (int ch = 0; ch < NCH; ++ch)
#pragma unroll
        for (int s = 0; s < 2; ++s) { const bf16x8 k0 = *(const LAS bf16x8*)(kp + (ATT_ROWOFF(ch) + 4 * s) * KP), k1 = *(const LAS bf16x8*)(kp + (ATT_ROWOFF(ch) + 4 * s) * KP + 64);
            f32x4 acc = (f32x4){0.f, 0.f, 0.f, 0.f};
            acc = __builtin_amdgcn_mfma_f32_16x16x32_bf16(k0, q0, acc, 0, 0, 0);
            acc = __builtin_amdgcn_mfma_f32_16x16x32_bf16(k1, q1, acc, 0, 0, 0);
            S[ch][s] = acc; } }
    float mx = -1e30f;
    if (KIND != 1) {
        const LAS float* lp = lut + (krow0 - p0 + 8 * G); const LAS float* pp = pen + (krow0 + 8 * G);
#pragma unroll
        for (int ch = 0; ch < NCH; ++ch)
#pragma unroll
            for (int s = 0; s < 2; ++s) { const f32x4 pn = *(const LAS f32x4*)(pp + ATT_ROWOFF(ch) + 4 * s);
#pragma unroll
                for (int e = 0; e < 4; ++e) { const float v = (S[ch][s][e] * 0.125f + lp[32 * ch + 4 * s + e]) + pn[e]; S[ch][s][e] = v; mx = fmaxf(mx, v); } }
    } else
#pragma unroll
    for (int ch = 0; ch < NCH; ++ch) {
#pragma unroll
        for (int s = 0; s < 2; ++s)
#pragma unroll
            for (int e = 0; e < 4; ++e) { const int kc = 8 * G + 4 * s + e; bool ok; float bv;
                const int col = p3 + kc, idx = col - p0 + 15; ok = (unsigned)(col - p1) < 16u; const int ic = idx < 0 ? 0 : (idx > 30 ? 30 : idx); bv = lut[(ch + p2) * 31 + ic];
                const float v = (S[ch][s][e] * 0.125f + bv) + (ok ? 0.f : -1e30f); S[ch][s][e] = v; mx = fmaxf(mx, v); }
    }
    mx = fmaxf(mx, __shfl_xor(mx, 16)); mx = fmaxf(mx, __shfl_xor(mx, 32));
    float sum = 0.f;
#pragma unroll
    for (int ch = 0; ch < NCH; ++ch)
#pragma unroll
        for (int s = 0; s < 2; ++s)
#pragma unroll
            for (int e = 0; e < 4; ++e) { const float p = __builtin_amdgcn_exp2f((S[ch][s][e] - mx) * 1.44269504089f); S[ch][s][e] = p; sum += p; }
    sum += __shfl_xor(sum, 16); sum += __shfl_xor(sum, 32);
    if (KIND == 2) sum += __builtin_amdgcn_exp2f((sinkv - mx) * 1.44269504089f);
#pragma unroll
    for (int db = 0; db < 4; ++db) O[db] = (f32x4){0.f, 0.f, 0.f, 0.f};
    { ldscp vp = Vs + (krow0 + 8 * G + (i16 >> 2)) * VP + 8 * (i16 & 3);
#pragma unroll
      for (int ch = 0; ch < NCH; ++ch) {
        u32x4 pw; pw.x = cvtpk(S[ch][0][0], S[ch][0][1]); pw.y = cvtpk(S[ch][0][2], S[ch][0][3]); pw.z = cvtpk(S[ch][1][0], S[ch][1][1]); pw.w = cvtpk(S[ch][1][2], S[ch][1][3]);
        const bf16x8 pb = __builtin_bit_cast(bf16x8, pw);
#pragma unroll
        for (int db = 0; db < 4; ++db) { const s16x4 vl = vtr(vp + ATT_ROWOFF(ch) * VP + 32 * db), vh = vtr(vp + (ATT_ROWOFF(ch) + 4) * VP + 32 * db);
            const bf16x8 va = (bf16x8){vl[0], vl[1], vl[2], vl[3], vh[0], vh[1], vh[2], vh[3]};
            O[db] = __builtin_amdgcn_mfma_f32_16x16x32_bf16(va, pb, O[db], 0, 0, 0); } } }
    mo = mx; lo = sum;
#undef ATT_ROWOFF
}
__device__ __forceinline__ float xmax16(float v) { auto r = __builtin_amdgcn_permlane16_swap(__builtin_bit_cast(unsigned, v), __builtin_bit_cast(unsigned, v), false, false); return fmaxf(__builtin_bit_cast(float, r[0]), __builtin_bit_cast(float, r[1])); }
__device__ __forceinline__ float xmax32(float v) { auto r = __builtin_amdgcn_permlane32_swap(__builtin_bit_cast(unsigned, v), __builtin_bit_cast(unsigned, v), false, false); return fmaxf(__builtin_bit_cast(float, r[0]), __builtin_bit_cast(float, r[1])); }
__device__ __forceinline__ float xadd16(float v) { auto r = __builtin_amdgcn_permlane16_swap(__builtin_bit_cast(unsigned, v), __builtin_bit_cast(unsigned, v), false, false); return __builtin_bit_cast(float, r[0]) + __builtin_bit_cast(float, r[1]); }
__device__ __forceinline__ float xadd32(float v) { auto r = __builtin_amdgcn_permlane32_swap(__builtin_bit_cast(unsigned, v), __builtin_bit_cast(unsigned, v), false, false); return __builtin_bit_cast(float, r[0]) + __builtin_bit_cast(float, r[1]); }
template <int NCH>
__device__ __forceinline__ void attn_wave_dual(ldscp Ks, ldscp Vs, const LAS float* lut, const LAS float* pen, const bf16x8 (&q)[2][2], int krow0a, int krow0b, int p0a, int p0b,
                                               f32x4 (&O)[2][4], float (&mo)[2], float (&lo)[2], int lane) {
    const int i16 = lane & 15, G = lane >> 4;
    f32x4 S[2][NCH][2];
    ldscp kp[2]; kp[0] = Ks + (krow0a + 8 * (i16 >> 2) + (i16 & 3)) * KP + 16 * G; kp[1] = Ks + (krow0b + 8 * (i16 >> 2) + (i16 & 3)) * KP + 16 * G;
#pragma unroll
    for (int ch = 0; ch < NCH; ++ch)
#pragma unroll
        for (int s = 0; s < 2; ++s)
#pragma unroll
            for (int t = 0; t < 2; ++t) { const bf16x8 k0 = *(const LAS bf16x8*)(kp[t] + (32 * ch + 4 * s) * KP), k1 = *(const LAS bf16x8*)(kp[t] + (32 * ch + 4 * s) * KP + 64);
                f32x4 acc = (f32x4){0.f, 0.f, 0.f, 0.f};
                acc = __builtin_amdgcn_mfma_f32_16x16x32_bf16(k0, q[t][0], acc, 0, 0, 0);
                acc = __builtin_amdgcn_mfma_f32_16x16x32_bf16(k1, q[t][1], acc, 0, 0, 0);
                S[t][ch][s] = acc; }
    float mx[2] = {-1e30f, -1e30f};
    const LAS float* lp[2]; lp[0] = lut + (krow0a - p0a + 8 * G); lp[1] = lut + (krow0b - p0b + 8 * G);
    const LAS float* pp[2]; pp[0] = pen + (krow0a + 8 * G); pp[1] = pen + (krow0b + 8 * G);
#pragma unroll
    for (int ch = 0; ch < NCH; ++ch)
#pragma unroll
        for (int s = 0; s < 2; ++s)
#pragma unroll
            for (int t = 0; t < 2; ++t) { const f32x4 pn = *(const LAS f32x4*)(pp[t] + 32 * ch + 4 * s);
#pragma unroll
                for (int e = 0; e < 4; ++e) { const float v = (S[t][ch][s][e] * 0.125f + lp[t][32 * ch + 4 * s + e]) + pn[e]; S[t][ch][s][e] = v; mx[t] = fmaxf(mx[t], v); } }
#pragma unroll
    for (int t = 0; t < 2; ++t) { mx[t] = fmaxf(mx[t], __shfl_xor(mx[t], 16)); mx[t] = fmaxf(mx[t], __shfl_xor(mx[t], 32)); }
    float sum[2] = {0.f, 0.f};
#pragma unroll
    for (int ch = 0; ch < NCH; ++ch)
#pragma unroll
        for (int s = 0; s < 2; ++s)
#pragma unroll
            for (int t = 0; t < 2; ++t)
#pragma unroll
                for (int e = 0; e < 4; ++e) { const float p = __builtin_amdgcn_exp2f((S[t][ch][s][e] - mx[t]) * 1.44269504089f); S[t][ch][s][e] = p; sum[t] += p; }
#pragma unroll
    for (int t = 0; t < 2; ++t) { sum[t] += __shfl_xor(sum[t], 16); sum[t] += __shfl_xor(sum[t], 32); }
#pragma unroll
    for (int t = 0; t < 2; ++t)
#pragma unroll
        for (int db = 0; db < 4; ++db) O[t][db] = (f32x4){0.f, 0.f, 0.f, 0.f};
    ldscp vp[2]; vp[0] = Vs + (krow0a + 8 * G + (i16 >> 2)) * KP + 8 * (i16 & 3); vp[1] = Vs + (krow0b + 8 * G + (i16 >> 2)) * KP + 8 * (i16 & 3);
#pragma unroll
    for (int ch = 0; ch < NCH; ++ch) {
        bf16x8 pb[2];
#pragma unroll
        for (int t = 0; t < 2; ++t) { u32x4 pw; pw.x = cvtpk(S[t][ch][0][0], S[t][ch][0][1]); pw.y = cvtpk(S[t][ch][0][2], S[t][ch][0][3]); pw.z = cvtpk(S[t][ch][1][0], S[t][ch][1][1]); pw.w = cvtpk(S[t][ch][1][2], S[t][ch][1][3]);
            pb[t] = __builtin_bit_cast(bf16x8, pw); }
#pragma unroll
        for (int db = 0; db < 4; ++db)
#pragma unroll
            for (int t = 0; t < 2; ++t) { const s16x4 vl = vtr(vp[t] + (32 * ch) * KP + 32 * db), vh = vtr(vp[t] + (32 * ch + 4) * KP + 32 * db);
                const bf16x8 va = (bf16x8){vl[0], vl[1], vl[2], vl[3], vh[0], vh[1], vh[2], vh[3]};
                O[t][db] = __builtin_amdgcn_mfma_f32_16x16x32_bf16(va, pb[t], O[t][db], 0, 0, 0); } }
#pragma unroll
    for (int t = 0; t < 2; ++t) { mo[t] = mx[t]; lo[t] = sum[t]; }
}
__device__ __forceinline__ void attn_store(bf16* orow, const f32x4 (&O)[4], float inv, int lane) {
    const int G = lane >> 4; const bool odd = (G & 1) != 0;
#pragma unroll
    for (int k = 0; k < 2; ++k) { u32x2 w0, w1;
        w0.x = cvtpk(O[2 * k][0] * inv, O[2 * k][1] * inv); w0.y = cvtpk(O[2 * k][2] * inv, O[2 * k][3] * inv);
        w1.x = cvtpk(O[2 * k + 1][0] * inv, O[2 * k + 1][1] * inv); w1.y = cvtpk(O[2 * k + 1][2] * inv, O[2 * k + 1][3] * inv);
        const u32x2 snd = odd ? w0 : w1; u32x2 rcv; rcv.x = __shfl_xor(snd.x, 16); rcv.y = __shfl_xor(snd.y, 16);
        u32x4 o; if (odd) { o.x = rcv.x; o.y = rcv.y; o.z = w1.x; o.w = w1.y; } else { o.x = w0.x; o.y = w0.y; o.z = rcv.x; o.w = rcv.y; }
        *(u32x4*)(orow + 16 * (2 * k) + (odd ? 16 + 4 * (G - 1) : 4 * G)) = o; }
}

__device__ __forceinline__ void attnA_phase(const bf16* qkv, bf16* ao, float* lse, const float* lutA, int g, int half, ldsp lds, int tid, int wave, int lane, int G, int bid) {
    const int i16 = lane & 15, Gq = lane >> 4; constexpr int NU = (NB / 2) * 16 * 16;
    const int dsh = 2 * g, L = SEQ >> dsh, lb = 4 - dsh; ao += (size_t)half * (MTOK / 2) * DM; lse += (size_t)half * (MTOK / 2) * 16;
    u32x4 kr[6], vr[6]; bf16x8 qa0 = (bf16x8){0, 0, 0, 0, 0, 0, 0, 0}, qa1 = qa0, qb0 = qa0, qb1 = qa0; float lutv = 0.f; unsigned vmask = 0u;
#define A_DECODE(uu) const int rb = (uu) & 15; const int head = ((uu) >> 4) & 15, bl = (uu) >> 8; \
        const int res = rb >> lb, j0 = (rb & ((1 << lb) - 1)) * 256; \
        const int qi = 32 * wave + i16; const size_t qrowa = (size_t)bl * SEQ + (((j0 + qi) << dsh) + res), qrowb = (size_t)bl * SEQ + (((j0 + 16 + qi) << dsh) + res);
#define A_PREFETCH(uu) { A_DECODE(uu) const bf16* base = qkv + (size_t)bl * SEQ * NG_IN + head * 64; \
        _Pragma("unroll") for (int itx = 0; itx < 6; ++itx) { const int p_ = tid + NTHR * itx, row = p_ >> 3, pc = p_ & 7, j = j0 - 64 + row; const bool valid = (j >= 0) && (j < L); \
            kr[itx] = (u32x4){0u, 0u, 0u, 0u}; vr[itx] = kr[itx]; vmask = itx == 0 ? (valid ? 1u : 0u) : (vmask | (valid ? (1u << itx) : 0u)); \
            if (valid) { const bf16* rp = base + (size_t)((j << dsh) + res) * NG_IN + pc * 8; kr[itx] = *(const u32x4*)(rp + 1024); vr[itx] = *(const u32x4*)(rp + 2048); } } \
        lutv = (tid >= 127 && tid < 256) ? lutA[(g * 16 + head) * LUTA_P + tid - 127] : -1e30f; \
        const bf16* qp = qkv + qrowa * NG_IN + head * 64 + 8 * Gq; qa0 = *(const bf16x8*)qp; qa1 = *(const bf16x8*)(qp + 32); \
        const bf16* qp2 = qkv + qrowb * NG_IN + head * 64 + 8 * Gq; qb0 = *(const bf16x8*)qp2; qb1 = *(const bf16x8*)(qp2 + 32); }
    int u = (G & 7) ? bid : (bid & 7) * (G >> 3) + (bid >> 3);
    if (u < NU) A_PREFETCH(u)
    for (; u < NU; u += G) {
        __syncthreads();
#pragma unroll
        for (int itx = 0; itx < 6; ++itx) { const int p_ = tid + NTHR * itx, row = p_ >> 3, pc = p_ & 7; *(LAS u32x4*)(lds + LDS_K + row * KP + pc * 16) = kr[itx]; *(LAS u32x4*)(lds + LDS_V + row * KP + pc * 16) = vr[itx];
            if (pc == 0) ((LAS float*)(lds + LDS_LUT + 2048))[row] = ((vmask >> itx) & 1u) ? 0.f : -1e30f; }
        if (tid < 384) ((LAS float*)(lds + LDS_LUT))[tid] = lutv;
        const bf16x8 ca0 = qa0, ca1 = qa1, cb0 = qb0, cb1 = qb1;
        __syncthreads();
        if (u + G < NU) A_PREFETCH(u + G)
        A_DECODE(u)
        u32x2 po[2][4]; float pl[2] = {0.f, 0.f};
        if (g > 0) {
#pragma unroll
            for (int ps = 0; ps < 2; ++ps) { const size_t qrow = ps ? qrowb : qrowa; pl[ps] = lse[qrow * 16 + head];
#pragma unroll
                for (int db = 0; db < 4; ++db) po[ps][db] = *(const u32x2*)(ao + qrow * DM + head * 64 + 16 * db + 4 * Gq); } }
        { f32x4 O[2][4]; float mo[2], lo[2]; const bf16x8 qq[2][2] = {{ca0, ca1}, {cb0, cb1}};
          attn_wave_dual<5>(lds + LDS_K, lds + LDS_V, (const LAS float*)(lds + LDS_LUT) + 127, (const LAS float*)(lds + LDS_LUT + 2048), qq, 32 * wave, 32 * wave, qi, 16 + qi, O, mo, lo, lane);
#pragma unroll
          for (int ps = 0; ps < 2; ++ps) { const size_t qrow = ps ? qrowb : qrowa;
            const float ln = mo[ps] + logf(lo[ps]); float wn = 1.0f / lo[ps], wo = 0.f, lt = ln;
            if (g > 0) { const float mm = fmaxf(ln, pl[ps]), en = __expf(ln - mm), eo = __expf(pl[ps] - mm), inv = 1.0f / (en + eo); wn *= en * inv; wo = eo * inv; lt = mm + logf(en + eo);
#pragma unroll
                for (int db = 0; db < 4; ++db) { O[ps][db][0] = O[ps][db][0] * wn + wo * bf_lo(po[ps][db].x); O[ps][db][1] = O[ps][db][1] * wn + wo * bf_hi(po[ps][db].x);
                    O[ps][db][2] = O[ps][db][2] * wn + wo * bf_lo(po[ps][db].y); O[ps][db][3] = O[ps][db][3] * wn + wo * bf_hi(po[ps][db].y); }
                wn = 1.0f; }
            attn_store(ao + qrow * DM + head * 64, O[ps], wn, lane);
            if (Gq == 0) lse[qrow * 16 + head] = lt; } }
    }
#undef A_DECODE
#undef A_PREFETCH
}
__device__ __forceinline__ void attnC_phase(const bf16* qkv, bf16* ao, const float* lutC, const float* sink, ldsp lds, int tid, int wave, int lane, int G, int bid) {
    const int i16 = lane & 15, Gq = lane >> 4;
    constexpr int LDS_LUTC = 120064, LDS_PENC = LDS_LUTC + 20480;
    for (int i_ = tid; i_ < 16 * 320; i_ += NTHR) { const int h_ = i_ / 320, idx = i_ % 320 - 31; ((LAS float*)(lds + LDS_LUTC))[i_] = (idx >= 0 && idx <= 256) ? lutC[h_ * LUTC_P + idx] : -1e30f; }
    const int hh = wave & 3, qs = wave >> 2, qi = 16 * qs + i16;
    const int prow = (tid >> 3) & 31, ppc = tid & 7; const bool isv = tid >= 256;
    for (int it = (G & 7) ? bid : (bid & 7) * (G >> 3) + (bid >> 3); it < NB * 4 * 8; it += G) {
        const int seg = it & 7, hkv = (it >> 3) & 3, b = it >> 5, qb0 = 16 * seg, hq = hkv * 4 + hh;
        const bf16* base = qkv + (size_t)b * SEQ * NC_IN + 1024 + hkv * 64 + (isv ? 256 : 0) + ppc * 8;
        const float sk = sink[hq];
        __syncthreads();
        for (int ch = 0; ch < 9; ++ch) { const int cidx = qb0 - 4 + ch, pos = 32 * cidx + prow, sl = (cidx + 9) % 9; const bool valid = (pos >= 0) && (pos < SEQ);
            u32x4 d = (u32x4){0u, 0u, 0u, 0u}; if (valid) d = *(const u32x4*)(base + (size_t)pos * NC_IN);
            *(LAS u32x4*)(lds + (isv ? LDS_V : LDS_K) + (sl * 32 + prow) * KP + ppc * 16) = d;
            if (tid < 32) ((LAS float*)(lds + LDS_PENC))[sl * 32 + tid] = (32 * cidx + tid >= 0 && 32 * cidx + tid < SEQ) ? 0.f : -1e30f; }
        bf16x8 q0, q1;
        { const size_t qrow = (size_t)b * SEQ + 32 * qb0 + qi; const bf16* qp = qkv + qrow * NC_IN + hq * 64 + 8 * Gq; q0 = *(const bf16x8*)qp; q1 = *(const bf16x8*)(qp + 32); }
        u32x4 nd = (u32x4){0u, 0u, 0u, 0u};
        for (int st = 0; st < 16; ++st) {
            const int qb = qb0 + st;
            if (st > 0) { __syncthreads();
                const int cidx = qb + 4, sl = (cidx + 9) % 9;
                *(LAS u32x4*)(lds + (isv ? LDS_V : LDS_K) + (sl * 32 + prow) * KP + ppc * 16) = nd;
                if (tid < 32) ((LAS float*)(lds + LDS_PENC))[sl * 32 + tid] = (32 * cidx + tid < SEQ) ? 0.f : -1e30f; }
            const bf16x8 cq0 = q0, cq1 = q1;
            __syncthreads();
            if (st < 15) { const int pos = 32 * (qb + 5) + prow; nd = (u32x4){0u, 0u, 0u, 0u}; if (pos < SEQ) nd = *(const u32x4*)(base + (size_t)pos * NC_IN);
                const size_t qrow2 = (size_t)b * SEQ + 32 * (qb + 1) + qi; const bf16* qp = qkv + qrow2 * NC_IN + hq * 64 + 8 * Gq; q0 = *(const bf16x8*)qp; q1 = *(const bf16x8*)(qp + 32); }
            f32x4 O[4]; float mo, lo;
            attn_wave<2, 9>(lds + LDS_K, lds + LDS_V, (const LAS float*)(lds + LDS_LUTC) + hq * 320 + 31, (const LAS float*)(lds + LDS_PENC), cq0, cq1, 0, qi, (qb + 5) % 9, 0, 0, sk, O, mo, lo, lane);
            const size_t qrow = (size_t)b * SEQ + 32 * qb + qi;
            attn_store(ao + qrow * DM + hq * 64, O, 1.0f / lo, lane);
        }
    }
}
__device__ __forceinline__ void attnB_phase(const bf16* qkv, bf16* ao, const float* rpb, ldsp lds, int tid, int wave, int lane, int G, int bid) {
    constexpr int BK_OFF = 0, BV_OFF = 576 * KP, BVP = 128, BLUT_OFF = BV_OFF + 576 * BVP;
    const int i16 = lane & 15, Gq = lane >> 4, qs = wave & 3, wrow = wave >> 2, c = 16 * qs + i16;
    int cs = c - 8; cs = cs < 0 ? 0 : (cs > 48 ? 48 : cs);
    const int cw0 = qs == 0 ? 0 : (qs == 1 ? 8 : (qs == 2 ? 24 : 32));
    const int prow = tid >> 3, ppc = tid & 7;
    for (int it = (G & 7) ? bid : (bid & 7) * (G >> 3) + (bid >> 3); it < NB * 16 * 2; it += G) {
        const int half = it & 1, head = (it >> 1) & 15, b = it >> 5, rbase = 32 * half;
        const bf16* kbase = qkv + (size_t)b * SEQ * NB_IN + 1024 + head * 64 + ppc * 8;
        __syncthreads();
        if (tid < 465) ((LAS float*)(lds + BLUT_OFF))[tid] = rpb[head * 465 + tid];
        int hi;
        { int r0s = rbase - 4; r0s = r0s < 0 ? 0 : (r0s > 56 ? 56 : r0s); int r1s = rbase + 1 - 4; r1s = r1s < 0 ? 0 : (r1s > 56 ? 56 : r1s); hi = r1s + 7;
          for (int R = r0s; R <= hi; ++R) { const bf16* rp = kbase + (size_t)(64 * R + prow) * NB_IN; const u32x4 kv = *(const u32x4*)rp, vv = *(const u32x4*)(rp + 1024); const int sl = R % 9;
              *(LAS u32x4*)(lds + BK_OFF + (sl * 64 + prow) * KP + ppc * 16) = kv; *(LAS u32x4*)(lds + BV_OFF + (sl * 64 + prow) * BVP + ppc * 16) = vv; } }
        bf16x8 q0, q1;
        { const size_t qrow = (size_t)b * SEQ + (rbase + wrow) * 64 + c; const bf16* qp = qkv + qrow * NB_IN + head * 64 + 8 * Gq; q0 = *(const bf16x8*)qp; q1 = *(const bf16x8*)(qp + 32); }
        u32x4 nk[2], nv[2]; int nnew = 0;
        for (int st = 0; st < 16; ++st) {
            const int r = rbase + 2 * st + wrow; int rs = r - 4; rs = rs < 0 ? 0 : (rs > 56 ? 56 : rs);
            if (st > 0) { __syncthreads();
#pragma unroll
                for (int k = 0; k < 2; ++k) if (k < nnew) { const int sl = (hi + 1 + k) % 9;
                    *(LAS u32x4*)(lds + BK_OFF + (sl * 64 + prow) * KP + ppc * 16) = nk[k]; *(LAS u32x4*)(lds + BV_OFF + (sl * 64 + prow) * BVP + ppc * 16) = nv[k]; }
                hi += nnew; }
            const bf16x8 cq0 = q0, cq1 = q1;
            __syncthreads();
            nnew = 0;
            if (st < 15) {
                int r1n = rbase + 2 * st + 3 - 4; r1n = r1n < 0 ? 0 : (r1n > 56 ? 56 : r1n); nnew = r1n + 7 - hi;
#pragma unroll
                for (int k = 0; k < 2; ++k) if (k < nnew) { const bf16* rp = kbase + (size_t)(64 * (hi + 1 + k) + prow) * NB_IN; nk[k] = *(const u32x4*)rp; nv[k] = *(const u32x4*)(rp + 1024); }
                const size_t qrow2 = (size_t)b * SEQ + (r + 2) * 64 + c; const bf16* qp = qkv + qrow2 * NB_IN + head * 64 + 8 * Gq; q0 = *(const bf16x8*)qp; q1 = *(const bf16x8*)(qp + 32);
            }
            f32x4 O[4]; float mo, lo;
            attn_wave<1, 8, BVP>(lds + BK_OFF, lds + BV_OFF, (const LAS float*)(lds + BLUT_OFF), (const LAS float*)(lds + BLUT_OFF), cq0, cq1, cw0, c, cs, rs - r + 7, cw0, (float)(rs % 9), O, mo, lo, lane);
            const size_t qrow = (size_t)b * SEQ + r * 64 + c;
            attn_store(ao + qrow * DM + head * 64, O, 1.0f / lo, lane);
        }
    }
}

#define XB_TMO      128
#define XB_XCNT(j)  (256  + 64 * (j))
#define XB_XSUB(j)  (1280 + 64 * (j))
#define XB_XGEN(j)  (2304 + 64 * (j))
#define XB_TOP      3328
#define XB_TOPGEN   3392
#define XCD_BAR_WORDS 3456
#define XB_SPIN_CAP (1u << 18)

__device__ __forceinline__ unsigned xb_ld(unsigned* p)              { return __hip_atomic_load(p, __ATOMIC_RELAXED, __HIP_MEMORY_SCOPE_AGENT); }
__device__ __forceinline__ unsigned xb_add(unsigned* p, unsigned v) { return __hip_atomic_fetch_add(p, v, __ATOMIC_RELAXED, __HIP_MEMORY_SCOPE_AGENT); }
__device__ __forceinline__ unsigned xb_xcc_id() { return (unsigned)__builtin_amdgcn_s_getreg((3 << 11) | 20) & 0xFu; }
#define XB_SPIN(cond, bar) do { unsigned _sp = 0; while (cond) { __builtin_amdgcn_s_sleep(1); \
    if ((++_sp & 255u) == 0u) { if (xb_ld(&(bar)[XB_TMO])) break; if (_sp > XB_SPIN_CAP) { atomicAdd(&(bar)[XB_TMO], 1u); break; } } } } while (0)

struct XcdBarrier {
    unsigned* bar; unsigned x;
    volatile LAS unsigned* st;
};

__device__ __forceinline__ XcdBarrier xcd_barrier_post(unsigned* bar, volatile LAS unsigned* st) {
    XcdBarrier b; b.bar = bar; b.x = xb_xcc_id(); b.st = st;
    if (threadIdx.x == 0) (void)xb_add(&bar[XB_XCNT(b.x)], 1u);
    return b;
}
__device__ __forceinline__ void xcd_barrier_complete(unsigned* bar, unsigned x, unsigned& nloc, unsigned& nx) {
    const unsigned G = gridDim.x * gridDim.y * gridDim.z;
    unsigned sum, cnt, mine, sp = 0u;
    for (;;) {
        sum = 0u; cnt = 0u; mine = 0u;
#pragma unroll
        for (unsigned j = 0; j < 16; ++j) { const unsigned c = xb_ld(&bar[XB_XCNT(j)]); sum += c; cnt += (c > 0u) ? 1u : 0u; mine = (j == x) ? c : mine; }
        if (sum == G) break;
        __builtin_amdgcn_s_sleep(1);
        if ((++sp & 255u) == 0u) { if (xb_ld(&bar[XB_TMO])) break; if (sp > XB_SPIN_CAP) { atomicAdd(&bar[XB_TMO], 1u); break; } }
    }
    nloc = mine > 0u ? mine : 1u; nx = cnt > 0u ? cnt : 1u;
}

__device__ __forceinline__ void xcd_barrier(const XcdBarrier& b) {
    asm volatile("s_waitcnt vmcnt(0)" ::: "memory");
    __syncthreads();
    if (threadIdx.x == 0) {
        unsigned* bar = b.bar;
        __builtin_amdgcn_s_waitcnt(0);
        unsigned nloc = b.st[0], nx = b.st[1];
        if (nloc == 0u) { xcd_barrier_complete(bar, b.x, nloc, nx); b.st[0] = nloc; b.st[1] = nx; }
        const unsigned old = xb_add(&bar[XB_XSUB(b.x)], 1u);
        const unsigned gen = old / nloc;
        if (old + 1u == (gen + 1u) * nloc) {
            __builtin_amdgcn_fence(__ATOMIC_RELEASE, "agent");
            asm volatile("s_waitcnt vmcnt(0)" ::: "memory");
            const unsigned og = xb_add(&bar[XB_TOP], 1u);
            const unsigned tg = og / nx;
            if (og + 1u == (tg + 1u) * nx) xb_add(&bar[XB_TOPGEN], 1u);
            else XB_SPIN(xb_ld(&bar[XB_TOPGEN]) == tg, bar);
            __builtin_amdgcn_fence(__ATOMIC_ACQUIRE, "agent");
            xb_add(&bar[XB_XGEN(b.x)], 1u);
            asm volatile("s_waitcnt vmcnt(0)" ::: "memory");
        } else {
            XB_SPIN(xb_ld(&bar[XB_XGEN(b.x)]) == gen, bar);
            __builtin_amdgcn_fence(__ATOMIC_ACQUIRE, "agent");
            asm volatile("s_waitcnt vmcnt(0)" ::: "memory");
        }
    }
    __syncthreads();
}

#ifndef ENMASK
#define ENMASK 0xff
#endif
#define EN(i) ((ENMASK >> (i)) & 1)
#ifndef REPMASK
#define REPMASK 0
#endif
#define REP(i) ((REPMASK >> (i)) & 1)
enum { PH_PRO = 0, PH_N0, PH_GQKV, PH_ATT, PH_OP, PH_F1, PH_F2, PH_FIN };
constexpr int NPHASES = 2 + 15 + 5 + 5 + 15 + 1;

__global__ void __launch_bounds__(NTHR, 2) mk_fwd(Args a) {
    extern __shared__ __attribute__((aligned(16))) unsigned char lds_raw[];
    ldsp lds0 = (ldsp)lds_raw;
    volatile LAS unsigned* bst = (volatile LAS unsigned*)(lds0 + LDS_BARST);
    if (threadIdx.x < 16) bst[threadIdx.x] = 0u;
    __syncthreads();
    XcdBarrier xbar = xcd_barrier_post((unsigned*)KWS(), bst);
#define WSP(T, off) ((T*)(KWS() + (off)))
    const int plo = (int)(((kargp)__builtin_amdgcn_kernarg_segment_ptr())[20] & 0xffffffffull), phi = (int)(((kargp)__builtin_amdgcn_kernarg_segment_ptr())[20] >> 32);
    for (int p = plo; p < phi; ++p) {
        int kind, layer = 0, chunk = 0;
        if (p == 0) kind = PH_PRO; else if (p == 1) kind = PH_N0; else if (p == NPHASES - 1) kind = PH_FIN;
        else { int q = p - 2; if (q < 15) layer = 0; else if (q < 20) { layer = 1; q -= 15; } else if (q < 25) { layer = 2; q -= 20; } else { layer = 3; q -= 25; }
            if (layer == 0 || layer == 3) { if (q < 12) { chunk = q >> 1; kind = (q & 1) ? PH_ATT : PH_GQKV; } else kind = PH_OP + (q - 12); }
            else { kind = q == 0 ? PH_GQKV : (q == 1 ? PH_ATT : PH_OP + (q - 2)); } }
        const int mk = layer % 3, mj = layer / 3;
        const float* xcur = (layer == 0 && kind == PH_OP) ? KIN(0) : KOUT();
        const float* modl = WSP(const float, WS_MOD) + (size_t)layer * 8 * 6144;
        const int nrep = 1 + ((kind == PH_PRO && REP(0)) || (kind == PH_N0 && REP(1)) || (kind == PH_GQKV && REP(2)) || (kind == PH_ATT && mk == 0 && REP(3)) || (kind == PH_ATT && mk == 1 && REP(4)) ||
                              (kind == PH_ATT && mk == 2 && REP(5)) || (kind == PH_F1 && REP(7)) || ((kind == PH_OP || kind == PH_F2) && REP(6)) ? 1 : 0);
        for (int rep = 0; rep < nrep; ++rep) {
        int tid = threadIdx.x; asm volatile("" : "+v"(tid));
        int G = gridDim.x, bid = blockIdx.x; unsigned lo_ = 0; asm volatile("" : "+s"(G), "+s"(bid), "+s"(lo_));
        ldsp lds = lds0 + lo_;
        const int lane = tid & 63, wave = __builtin_amdgcn_readfirstlane(tid >> 6);
        if (kind == PH_PRO && EN(0)) prologue(lds, tid, wave, lane, G, bid);
        else if (kind == PH_N0 && EN(1)) norm0_phase(tid, wave, lane, G, bid);
        else if (kind == PH_FIN && EN(1)) fin_phase(wave, lane, G, bid);
        else if (kind == PH_GQKV && EN(2)) {
            const int N = mk == 0 ? NG_IN : (mk == 1 ? NB_IN : NC_IN), M = mk == 0 ? MTOK / 2 : MTOK, grp = chunk >> 1, roff = mk == 0 ? (chunk & 1) * (MTOK / 2) : 0;
            const bf16* wt = WSP(bf16, WS_W) + (mk == 0 ? W_AIN + (size_t)mj * NA_IN * DM + (size_t)grp * NG_IN * DM : (mk == 1 ? W_BIN : W_CIN));
            pg8::Gemm g{WSP(bf16, WS_XN) + (size_t)roff * DM, wt, M, N, DM}; pg8::StaticOrder S; S.init(M, N, G, bid);
            pg8::EpiStoreBf16 E{WSP(bf16, WS_BIG), N, WSP(const float, WS_SS) + (size_t)(2 * layer) * MTOK, WSP(const float, WS_BIAS) + (size_t)(2 * layer) * 8 * BIAS_LD + (mk == 0 ? grp * NG_IN : 0), roff};
            pg8::gemm_phase<pg8::EpiStoreBf16, pg8::StaticOrder, true, true>(lds, g, S, E);
        }
        else if (kind == PH_ATT) {
            if (mk == 0 && EN(3)) attnA_phase(WSP(bf16, WS_BIG), WSP(bf16, WS_AO), WSP(float, WS_LSE), WSP(const float, WS_LUT), chunk >> 1, chunk & 1, lds, tid, wave, lane, G, bid);
            else if (mk == 1 && EN(4)) attnB_phase(WSP(bf16, WS_BIG), WSP(bf16, WS_AO), KIN(12), lds, tid, wave, lane, G, bid);
            else if (EN(5)) attnC_phase(WSP(bf16, WS_BIG), WSP(bf16, WS_AO), WSP(const float, WS_LUT) + LUTC_OFF, KIN(15), lds, tid, wave, lane, G, bid);
        }
        else if ((kind == PH_OP || kind == PH_F2) && EN(6)) {
            const bool op = kind == PH_OP;
            const bf16* wt = WSP(bf16, WS_W) + (op ? (mk == 0 ? W_AOUT + (size_t)mj * DM * DM : (mk == 1 ? W_BOUT : W_COUT)) : W_F2 + (size_t)layer * DM * DFF);
            pg8::Gemm g{op ? WSP(bf16, WS_AO) : WSP(bf16, WS_BIG), wt, MTOK, DM, op ? DM : DFF}; pg8::StaticOrder S; S.init(MTOK, DM, G, bid);
            const int nidx = 2 * layer + (op ? 1 : 2);
            const bool dummy = REP(6) && rep == 0;
            pg8::EpiResid E{xcur, dummy ? (op ? WSP(float, WS_BIG) : WSP(float, WS_XN)) : KOUT(), modl + (op ? 2048 : 5120), WSP(const float, WS_WV) + (size_t)nidx * 8 * 1024, (nidx == 8 || dummy) ? (bf16*)nullptr : WSP(bf16, WS_XN), WSP(float, WS_SS) + (size_t)(dummy ? 12 : nidx) * MTOK};
            pg8::gemm_phase<pg8::EpiResid, pg8::StaticOrder, true, true>(lds, g, S, E);
        }
        else if (kind == PH_F1 && EN(7)) {
            pg8::Gemm g{WSP(bf16, WS_XN), WSP(bf16, WS_W) + W_F1 + (size_t)layer * NFF2 * DM, MTOK, NFF2, DM}; pg8::StaticOrder S; S.init(MTOK, NFF2, G, bid);
            pg8::EpiSwiglu E{WSP(bf16, WS_BIG), DFF, WSP(const float, WS_SS) + (size_t)(2 * layer + 1) * MTOK, WSP(const float, WS_BIAS) + (size_t)(2 * layer + 1) * 8 * BIAS_LD};
            pg8::gemm_phase<pg8::EpiSwiglu, pg8::StaticOrder, true, true>(lds, g, S, E);
        }
        }
        if (p + 1 < phi) { if (p == plo) cg::this_grid().sync(); else xcd_barrier(xbar); }
    }
}

extern "C" void kernel_launch(void* const* d_in, const int* in_sizes, int n_in, void* d_out, int out_size, void* d_ws, size_t ws_size, hipStream_t stream) {
    static int grid = 0;
    if (grid == 0) {
        if (n_in != 18 || in_sizes[0] != MTOK * DM || out_size != MTOK * DM || ws_size < WS_END) { fprintf(stderr, "kernel_launch: unexpected shapes / workspace (n_in %d, ws %zu)\n", n_in, ws_size); grid = -1; return; }
        int dev = 0, cus = 0, per_cu = 0;
        (void)hipGetDevice(&dev); (void)hipDeviceGetAttribute(&cus, hipDeviceAttributeMultiprocessorCount, dev);
        if (hipFuncSetAttribute((const void*)mk_fwd, hipFuncAttributeMaxDynamicSharedMemorySize, LDS_BYTES) != hipSuccess) { fprintf(stderr, "kernel_launch: hipFuncSetAttribute failed\n"); grid = -1; return; }
        if (hipOccupancyMaxActiveBlocksPerMultiprocessor(&per_cu, (const void*)mk_fwd, NTHR, LDS_BYTES) != hipSuccess || per_cu < 1) { fprintf(stderr, "kernel_launch: occupancy query says %d\n", per_cu); per_cu = 1; }
        (void)hipGetLastError();
        grid = cus * per_cu;
        fprintf(stderr, "kernel_launch: grid %d (cus %d x %d)\n", grid, cus, per_cu);
    }
    if (grid < 0) return;
    if (hipMemsetAsync(d_ws, 0, 65536, stream) != hipSuccess || hipMemsetAsync((char*)d_ws + WS_SS, 0, 2 * MiB, stream) != hipSuccess) { fprintf(stderr, "kernel_launch: memset failed\n"); return; }
    Args a{};
    for (int i = 0; i < 18; ++i) a.in[i] = (const float*)d_in[i];
    a.out = (float*)d_out; a.ws = (unsigned char*)d_ws;
#if MK_PER_PHASE_LAUNCH
    for (int p = 0; p < NPHASES; ++p) { a.lo = p; a.hi = p + 1; hipLaunchKernelGGL(mk_fwd, dim3(grid), dim3(NTHR), LDS_BYTES, stream, a); }
#else
    a.lo = 0; a.hi = NPHASES;
    void* args[] = {&a};
    hipError_t e = hipLaunchCooperativeKernel((const void*)mk_fwd, dim3(grid), dim3(NTHR), args, LDS_BYTES, stream);
    if (e != hipSuccess) fprintf(stderr, "cooperative launch failed: %s (grid %d)\n", hipGetErrorString(e), grid);
#endif
}
```

```cpp
#include <hip/hip_runtime.h>
#include <hip/hip_cooperative_groups.h>
#include <cstdio>
#include <cstdint>
#include <cmath>
namespace cg = cooperative_groups;
namespace pg8 {
#define PG8_LAS __attribute__((address_space(3)))
typedef unsigned short bf16_t;
typedef short bf16x8 __attribute__((ext_vector_type(8)));
typedef float f32x4 __attribute__((ext_vector_type(4)));
typedef unsigned u32x4 __attribute__((ext_vector_type(4)));
constexpr int BM = 256, BK = 64, HALF = 128, HTB = HALF * BK * 2  , STAGE_BYTES = 8 * HTB, NXCD = 8, WGM = 8;

__host__ __device__ __forceinline__ int lds_byte(int r, int c) { const int st = (r >> 4) * 2 + (c >> 5), rr = r & 15, cc = c & 31, ob = rr * 64 + cc * 2; return st * 1024 + (ob ^ (((ob >> 9) & 1) << 5)); }
__host__ __device__ __forceinline__ void stage_rc(int b, int& R, int& C) { const int st = b / 1024, sb = b % 1024, swz = sb ^ (((sb >> 9) & 1) << 5); R = (st >> 1) * 16 + swz / 64; C = (st & 1) * 32 + (swz % 64) / 2; }
__host__ __device__ __forceinline__ int perm32(int rho) { const int n = rho >> 4, i = rho & 15; return 8 * (i >> 2) + 4 * n + (i & 3); }

struct Unit { int pm, pn; };
struct Gemm { const bf16_t* A; const bf16_t* Bt; int M, N, K; };

struct StaticOrder {
    int nM, nN, nwg, G, c;
    __host__ __device__ void init(int M, int N, int G_, int c_) { nM = M / BM; nN = N / BM; nwg = nM * nN; G = G_; c = c_; }
    __host__ __device__ bool next(int i, Unit& u) const {
        const long L = (long)i * G + c; if (L >= nwg) return false;
        int wgid = (int)L; { const int q = nwg / NXCD, r = nwg % NXCD, xcd = wgid % NXCD, off = wgid / NXCD; wgid = (xcd < r ? xcd * (q + 1) : r * (q + 1) + (xcd - r) * q) + off; }
        const int nig = WGM * nN, gid = wgid / nig, fm = gid * WGM, gsz = (nM - fm) < WGM ? (nM - fm) : WGM;
        u.pm = fm + ((wgid % nig) % gsz); u.pn = (wgid % nig) / gsz; return true;
    }
    __device__ __forceinline__ void a_ready(const Unit&) const {}
    __device__ __forceinline__ void done(const Unit&) const {}
};

__device__ __forceinline__ unsigned cvt_pk_bf16(float lo, float hi) { unsigned r; asm volatile("v_cvt_pk_bf16_f32 %0, %1, %2" : "=v"(r) : "v"(lo), "v"(hi)); return r; }
typedef float f32x2 __attribute__((ext_vector_type(2)));
constexpr int BIAS_LD = 9216;
typedef unsigned u32x2 __attribute__((ext_vector_type(2)));
struct EpiStoreBf16 {
    static constexpr bool PERM = true, AFTER_DRAIN = false;
    bf16_t* O; int ldc; const float* ss; const float* bias; int roff;
    __device__ __forceinline__ void operator()(const f32x4 (&acc)[2][2][4][2], const Unit& u, int wr, int wc, int fr, int fq) const {
        const int row0 = u.pm * BM + wr * 64 + fr; const int col0 = u.pn * BM + wc * 32 + 8 * fq;
        const float* bp = bias + (size_t)((roff + u.pm * BM) >> 12) * BIAS_LD + col0;
        f32x4 bv[2][2];
#pragma unroll
        for (int bj = 0; bj < 2; ++bj)
#pragma unroll
            for (int n = 0; n < 2; ++n) bv[bj][n] = *(const f32x4*)(bp + bj * HALF + 4 * n);
        float rsv[2][4];
#pragma unroll
        for (int ai = 0; ai < 2; ++ai)
#pragma unroll
            for (int m = 0; m < 4; ++m) rsv[ai][m] = ss[roff + row0 + ai * HALF + m * 16];
#pragma unroll
        for (int ai = 0; ai < 2; ++ai)
#pragma unroll
            for (int m = 0; m < 4; ++m) { const int r = row0 + ai * HALF + m * 16; bf16_t* rowp = O + (size_t)r * ldc + col0;
                const float rs = __builtin_amdgcn_rsqf(rsv[ai][m] * (1.0f / 1024.0f) + 1e-6f);
#pragma unroll
                for (int bj = 0; bj < 2; ++bj) { const f32x4 v0 = acc[ai][bj][m][0] * rs + bv[bj][0], v1 = acc[ai][bj][m][1] * rs + bv[bj][1];
                    u32x4 w; w.x = cvt_pk_bf16(v0[0], v0[1]); w.y = cvt_pk_bf16(v0[2], v0[3]); w.z = cvt_pk_bf16(v1[0], v1[1]); w.w = cvt_pk_bf16(v1[2], v1[3]);
                    *(u32x4*)(rowp + bj * HALF) = w; } }
    }
};
__device__ __forceinline__ float silu_f(float x) { return x * __builtin_amdgcn_rcpf(1.0f + __builtin_amdgcn_exp2f(-1.44269504089f * x)); }
struct EpiSwiglu {
    static constexpr bool PERM = true, AFTER_DRAIN = false;
    bf16_t* H; int ldh; const float* ss; const float* bias;
    __device__ __forceinline__ void operator()(const f32x4 (&acc)[2][2][4][2], const Unit& u, int wr, int wc, int fr, int fq) const {
        const int row0 = u.pm * BM + wr * 64 + fr; const int col0 = u.pn * HALF + wc * 32 + 8 * fq;
        const float* bp = bias + (size_t)((u.pm * BM) >> 12) * BIAS_LD + u.pn * BM + wc * 32 + 8 * fq;
        f32x4 bv[2][2];
#pragma unroll
        for (int bj = 0; bj < 2; ++bj)
#pragma unroll
            for (int n = 0; n < 2; ++n) bv[bj][n] = *(const f32x4*)(bp + bj * HALF + 4 * n);
        float rsv[2][4];
#pragma unroll
        for (int ai = 0; ai < 2; ++ai)
#pragma unroll
            for (int m = 0; m < 4; ++m) rsv[ai][m] = ss[row0 + ai * HALF + m * 16];
#pragma unroll
        for (int ai = 0; ai < 2; ++ai)
#pragma unroll
            for (int m = 0; m < 4; ++m) { const int r = row0 + ai * HALF + m * 16; bf16_t* rowp = H + (size_t)r * ldh + col0;
                const float rs = __builtin_amdgcn_rsqf(rsv[ai][m] * (1.0f / 1024.0f) + 1e-6f);
                const f32x4 g0 = acc[ai][0][m][0] * rs + bv[0][0], g1 = acc[ai][0][m][1] * rs + bv[0][1], u0 = acc[ai][1][m][0] * rs + bv[1][0], u1 = acc[ai][1][m][1] * rs + bv[1][1];
                u32x4 w; w.x = cvt_pk_bf16(silu_f(g0[0]) * u0[0], silu_f(g0[1]) * u0[1]); w.y = cvt_pk_bf16(silu_f(g0[2]) * u0[2], silu_f(g0[3]) * u0[3]);
                w.z = cvt_pk_bf16(silu_f(g1[0]) * u1[0], silu_f(g1[1]) * u1[1]); w.w = cvt_pk_bf16(silu_f(g1[2]) * u1[2], silu_f(g1[3]) * u1[3]);
                *(u32x4*)rowp = w; }
    }
};
struct EpiResid {
    static constexpr bool PERM = false, AFTER_DRAIN = false;
    const float* xin; float* xout; const float* gate; const float* wv; bf16_t* xn; float* ssn;
    __device__ __forceinline__ void operator()(const f32x4 (&acc)[2][2][4][2], const Unit& u, int wr, int wc, int fr, int fq) const {
        const int col0 = u.pn * BM + wc * 32 + 4 * fq; const int b = (u.pm * BM) >> 12;
        f32x4 gv[2][2], wvv[2][2];
#pragma unroll
        for (int bj = 0; bj < 2; ++bj)
#pragma unroll
            for (int n = 0; n < 2; ++n) { gv[bj][n] = *(const f32x4*)(gate + (size_t)b * 6144 + col0 + bj * HALF + n * 16); wvv[bj][n] = *(const f32x4*)(wv + (size_t)b * 1024 + col0 + bj * HALF + n * 16); }
        f32x4 xb[2][2][2];
        { const size_t off0 = (size_t)(u.pm * BM + wr * 64 + fr) * 1024 + col0;
#pragma unroll
          for (int bj = 0; bj < 2; ++bj)
#pragma unroll
            for (int n = 0; n < 2; ++n) xb[0][bj][n] = *(const f32x4*)(xin + off0 + bj * HALF + n * 16); }
#pragma unroll
        for (int rg = 0; rg < 8; ++rg) { const int ai = rg >> 2, m = rg & 3; const int row = u.pm * BM + ai * HALF + wr * 64 + m * 16 + fr; const size_t off = (size_t)row * 1024 + col0; float sp = 0.f;
            if (rg < 7) { const int ai2 = (rg + 1) >> 2, m2 = (rg + 1) & 3; const size_t off2 = (size_t)(u.pm * BM + ai2 * HALF + wr * 64 + m2 * 16 + fr) * 1024 + col0;
#pragma unroll
                for (int bj = 0; bj < 2; ++bj)
#pragma unroll
                    for (int n = 0; n < 2; ++n) xb[(rg + 1) & 1][bj][n] = *(const f32x4*)(xin + off2 + bj * HALF + n * 16); }
#pragma unroll
            for (int bj = 0; bj < 2; ++bj) { u32x2 wq[2];
#pragma unroll
                for (int n = 0; n < 2; ++n) { const f32x4 x1 = xb[rg & 1][bj][n] + gv[bj][n] * acc[ai][bj][m][n];
                    *(f32x4*)(xout + off + bj * HALF + n * 16) = x1; sp += (x1[0] * x1[0] + x1[1] * x1[1]) + (x1[2] * x1[2] + x1[3] * x1[3]);
                    const f32x4 y = x1 * wvv[bj][n]; wq[n].x = cvt_pk_bf16(y[0], y[1]); wq[n].y = cvt_pk_bf16(y[2], y[3]); }
                if (xn) {
                    const bool odd = (fq & 1) != 0; const u32x2 snd = odd ? wq[0] : wq[1]; u32x2 rcv; rcv.x = __shfl_xor(snd.x, 16); rcv.y = __shfl_xor(snd.y, 16);
                    u32x4 o; if (odd) { o.x = rcv.x; o.y = rcv.y; o.z = wq[1].x; o.w = wq[1].y; } else { o.x = wq[0].x; o.y = wq[0].y; o.z = rcv.x; o.w = rcv.y; }
                    *(u32x4*)(xn + off + bj * HALF + (odd ? 12 : 0)) = o; } }
            sp += __shfl_xor(sp, 16); sp += __shfl_xor(sp, 32);
            if (fq == 0) __hip_atomic_fetch_add(ssn + row, sp, __ATOMIC_RELAXED, __HIP_MEMORY_SCOPE_AGENT); }
    }
};
template <class Epi, class Sched, bool ALIGN_EPI = false, bool SP2 = false>
__device__ __forceinline__ void gemm_phase(PG8_LAS unsigned char* lds, const Gemm g, const Sched& S, const Epi& E) {
    int tid = threadIdx.x; asm volatile("" : "+v"(tid));
    const int wid = __builtin_amdgcn_readfirstlane(tid >> 6), lane = tid & 63, wr = wid >> 2, wc = wid & 3, fr = lane & 15, fq = lane >> 4;
    const int K = g.K, nt = K / BK;
    unsigned voffA[2], voffB[2];
#pragma unroll
    for (int i = 0; i < 2; ++i) { int R, C; stage_rc(tid * 16 + i * 8192, R, C); const int Rb = Epi::PERM ? ((R & ~31) + perm32(R & 31)) : R;
        voffA[i] = (unsigned)(R * K + C) * 2u; voffB[i] = (unsigned)(Rb * K + C) * 2u; }
    const size_t kstep = (size_t)(BK * 2);
    const size_t hstep = (size_t)HALF * K * 2;
    const size_t tstep = 2 * hstep;
    const unsigned ldsw = (unsigned)wid * 1024u;
    const int aoff = lds_byte(wr * 64 + fr, fq * 8), boff = lds_byte(wc * 32 + fr, fq * 8);
#define PG8_SA(b, h) (((b) * 2 + (h)) * HTB)
#define PG8_SB(b, h) ((4 + (b) * 2 + (h)) * HTB)
#define PG8_STAGE(bufoff, gbase, voff) do { _Pragma("unroll") for (int _i = 0; _i < 2; ++_i) \
        __builtin_amdgcn_global_load_lds((const unsigned*)((const char*)(gbase) + (voff)[_i]), (PG8_LAS unsigned*)(lds + (bufoff) + ldsw + _i * 8192), 16, 0, 0); } while (0)
#define PG8_LDA(dst, b, h) do { _Pragma("unroll") for (int m = 0; m < 4; ++m) _Pragma("unroll") for (int k = 0; k < 2; ++k) dst[m][k] = *(const PG8_LAS bf16x8*)(lds + PG8_SA(b, h) + aoff + m * 2048 + k * 1024); } while (0)
#define PG8_LDB(dst, b, h) do { _Pragma("unroll") for (int n = 0; n < 2; ++n) _Pragma("unroll") for (int k = 0; k < 2; ++k) dst[n][k] = *(const PG8_LAS bf16x8*)(lds + PG8_SB(b, h) + boff + n * 2048 + k * 1024); } while (0)
#define PG8_MMA(ai, bj, At, Bt) do { __builtin_amdgcn_s_setprio(1); _Pragma("unroll") for (int m = 0; m < 4; ++m) _Pragma("unroll") for (int n = 0; n < 2; ++n) _Pragma("unroll") for (int k = 0; k < 2; ++k) \
        acc[ai][bj][m][n] = __builtin_amdgcn_mfma_f32_16x16x32_bf16(Bt[n][k], At[m][k], acc[ai][bj][m][n], 0, 0, 0); __builtin_amdgcn_s_setprio(0); } while (0)
#define PG8_WAIT_V(n) asm volatile("s_waitcnt vmcnt(" #n ")" ::: "memory")
#define PG8_WAIT_L(n) asm volatile("s_waitcnt lgkmcnt(" #n ")" ::: "memory")
#define PG8_BAR __builtin_amdgcn_s_barrier()
#define PG8_SCHED __builtin_amdgcn_sched_barrier(0)
    Unit cur, nxt; int ui = 0;
    if (!S.next(0, cur)) return;
    f32x4 acc[2][2][4][2];
#pragma unroll
    for (int a = 0; a < 2; ++a)
#pragma unroll
        for (int b = 0; b < 2; ++b)
#pragma unroll
            for (int m = 0; m < 4; ++m)
#pragma unroll
                for (int n = 0; n < 2; ++n) acc[a][b][m][n] = (f32x4){0.f, 0.f, 0.f, 0.f};
    bf16x8 At[4][2], B0[2][2], B1[2][2];
    const char* cA = (const char*)g.A + (size_t)cur.pm * tstep; const char* cB = (const char*)g.Bt + (size_t)cur.pn * tstep;
    S.a_ready(cur);
    if constexpr (SP2) {
        PG8_STAGE(PG8_SB(0, 0), cB, voffB); PG8_STAGE(PG8_SB(0, 1), cB + hstep, voffB); PG8_STAGE(PG8_SA(0, 0), cA, voffA); PG8_STAGE(PG8_SA(0, 1), cA + hstep, voffA);
        if (wr == 1) PG8_BAR;
        PG8_WAIT_V(2); PG8_BAR;
        PG8_STAGE(PG8_SB(1, 0), cB + kstep, voffB); PG8_STAGE(PG8_SA(1, 0), cA + kstep, voffA); PG8_STAGE(PG8_SB(1, 1), cB + hstep + kstep, voffB);
        PG8_WAIT_V(6); PG8_BAR;
    } else {
        PG8_STAGE(PG8_SB(0, 0), cB, voffB); PG8_STAGE(PG8_SA(0, 0), cA, voffA); PG8_STAGE(PG8_SB(0, 1), cB + hstep, voffB); PG8_STAGE(PG8_SA(0, 1), cA + hstep, voffA);
        if (wr == 1) PG8_BAR;
        PG8_WAIT_V(4); PG8_BAR;
        PG8_STAGE(PG8_SB(1, 0), cB + kstep, voffB); PG8_STAGE(PG8_SA(1, 0), cA + kstep, voffA); PG8_STAGE(PG8_SB(1, 1), cB + hstep + kstep, voffB);
        PG8_WAIT_V(6); PG8_BAR;
    }
    for (;;) {
        const bool has_next = S.next(ui + 1, nxt);
        const char* nA = has_next ? (const char*)g.A + (size_t)nxt.pm * tstep : cA; const char* nB = has_next ? (const char*)g.Bt + (size_t)nxt.pn * tstep : cB;
        for (int t = 0; t < nt; t += 2) {
            const bool last = (t == nt - 2);
            const char* a1 = cA + (size_t)(t + 1) * kstep;
            const char* a2 = last ? nA : cA + (size_t)(t + 2) * kstep; const char* b2 = last ? nB : cB + (size_t)(t + 2) * kstep;
            const char* a3 = a2 + kstep; const char* b3 = b2 + kstep;
            if (last && has_next) S.a_ready(nxt);
            if constexpr (SP2) {
            PG8_LDB(B0, 0, 0); PG8_LDB(B1, 0, 1); PG8_SCHED; PG8_LDA(At, 0, 0); PG8_STAGE(PG8_SA(1, 1), a1 + hstep, voffA);
            PG8_WAIT_V(8); PG8_WAIT_L(0); PG8_BAR; PG8_MMA(0, 0, At, B0); PG8_MMA(0, 1, At, B1); PG8_BAR; PG8_SCHED;
            PG8_LDA(At, 0, 1); PG8_STAGE(PG8_SB(0, 0), b2, voffB); PG8_STAGE(PG8_SB(0, 1), b2 + hstep, voffB); PG8_STAGE(PG8_SA(0, 0), a2, voffA);
            PG8_WAIT_V(8); PG8_WAIT_L(0); PG8_BAR; PG8_MMA(1, 0, At, B0); PG8_MMA(1, 1, At, B1); PG8_BAR; PG8_SCHED;
            PG8_LDB(B0, 1, 0); PG8_LDB(B1, 1, 1); PG8_SCHED; PG8_LDA(At, 1, 0); PG8_STAGE(PG8_SA(0, 1), a2 + hstep, voffA);
            PG8_WAIT_V(8); PG8_WAIT_L(0); PG8_BAR; PG8_MMA(0, 0, At, B0); PG8_MMA(0, 1, At, B1); PG8_BAR; PG8_SCHED;
            PG8_LDA(At, 1, 1); PG8_STAGE(PG8_SB(1, 0), b3, voffB); PG8_STAGE(PG8_SB(1, 1), b3 + hstep, voffB); PG8_STAGE(PG8_SA(1, 0), a3, voffA);
            PG8_WAIT_V(8); PG8_WAIT_L(0); PG8_BAR; PG8_MMA(1, 0, At, B0); PG8_MMA(1, 1, At, B1); PG8_BAR; PG8_SCHED;
            } else {
            PG8_LDB(B0, 0, 0); PG8_SCHED; PG8_LDA(At, 0, 0); PG8_STAGE(PG8_SA(1, 1), a1 + hstep, voffA);
            PG8_WAIT_L(8); PG8_BAR; PG8_WAIT_L(0); PG8_MMA(0, 0, At, B0); PG8_BAR; PG8_SCHED;
            PG8_LDB(B1, 0, 1); PG8_STAGE(PG8_SB(0, 0), b2, voffB);
            PG8_BAR; PG8_WAIT_L(0); PG8_MMA(0, 1, At, B1); PG8_BAR;
            PG8_LDA(At, 0, 1); PG8_STAGE(PG8_SA(0, 0), a2, voffA);
            PG8_BAR; PG8_WAIT_L(0); PG8_MMA(1, 0, At, B0); PG8_BAR; PG8_SCHED;
            PG8_STAGE(PG8_SB(0, 1), b2 + hstep, voffB);
            PG8_WAIT_V(6); PG8_BAR; PG8_MMA(1, 1, At, B1); PG8_BAR;
            PG8_LDB(B0, 1, 0); PG8_SCHED; PG8_LDA(At, 1, 0); PG8_STAGE(PG8_SA(0, 1), a2 + hstep, voffA);
            PG8_WAIT_L(8); PG8_BAR; PG8_WAIT_L(0); PG8_MMA(0, 0, At, B0); PG8_BAR; PG8_SCHED;
            PG8_LDB(B1, 1, 1); PG8_STAGE(PG8_SB(1, 0), b3, voffB);
            PG8_BAR; PG8_WAIT_L(0); PG8_MMA(0, 1, At, B1); PG8_BAR;
            PG8_LDA(At, 1, 1); PG8_STAGE(PG8_SA(1, 0), a3, voffA);
            PG8_BAR; PG8_WAIT_L(0); PG8_MMA(1, 0, At, B0); PG8_BAR; PG8_SCHED;
            PG8_STAGE(PG8_SB(1, 1), b3 + hstep, voffB);
            PG8_WAIT_V(6); PG8_BAR; PG8_MMA(1, 1, At, B1); PG8_BAR;
            }
        }
        if constexpr (ALIGN_EPI) { if (wr == 0) PG8_BAR; }
        if constexpr (!Epi::AFTER_DRAIN) { E(acc, cur, wr, wc, fr, fq); S.done(cur); }
        if (!has_next) break;
#pragma unroll
        for (int a = 0; a < 2; ++a)
#pragma unroll
            for (int b = 0; b < 2; ++b)
#pragma unroll
                for (int m = 0; m < 4; ++m)
#pragma unroll
                    for (int n = 0; n < 2; ++n) acc[a][b][m][n] = (f32x4){0.f, 0.f, 0.f, 0.f};
        cur = nxt; cA = nA; cB = nB; ++ui;
        if constexpr (ALIGN_EPI) { if (wr == 1) PG8_BAR; }
    }
    PG8_WAIT_V(0);
    if constexpr (!ALIGN_EPI) { if (wr == 0) PG8_BAR; }
    PG8_BAR;
    if constexpr (Epi::AFTER_DRAIN) { E.fused(acc, cur, wr, wc, fr, fq, lds, wid, lane); S.done(cur); }
#undef PG8_SA
#undef PG8_SB
#undef PG8_STAGE
#undef PG8_LDA
#undef PG8_LDB
#undef PG8_MMA
#undef PG8_WAIT_V
#undef PG8_WAIT_L
#undef PG8_BAR
#undef PG8_SCHED
}
}

#ifndef MK_PER_PHASE_LAUNCH
#define MK_PER_PHASE_LAUNCH 0
#endif
#define LAS __attribute__((address_space(3)))
typedef unsigned short bf16;
typedef unsigned u32x4 __attribute__((ext_vector_type(4)));
typedef unsigned u32x2 __attribute__((ext_vector_type(2)));
typedef float f32x4 __attribute__((ext_vector_type(4)));
typedef short bf16x8 __attribute__((ext_vector_type(8)));
typedef short s16x4 __attribute__((ext_vector_type(4)));
typedef LAS unsigned char* ldsp;
typedef LAS const unsigned char* ldscp;

constexpr int NWAVES = 8, NTHR = 512;
constexpr int DM = 1024, NB = 8, SEQ = 4096, MTOK = NB * SEQ, DFF = 2816, NFF2 = 2 * DFF;
constexpr int NA_IN = 9216, NB_IN = 3072, NC_IN = 1536;
constexpr int NG_IN = 3072;
constexpr size_t MiB = 1u << 20;
constexpr size_t WS_MOD = 1 * MiB;
constexpr size_t WS_LUT = 2 * MiB;
constexpr size_t WS_W = 3 * MiB;
constexpr size_t W_AIN = 0, W_AOUT = W_AIN + 2ull * NA_IN * DM, W_BIN = W_AOUT + 2ull * DM * DM, W_BOUT = W_BIN + (size_t)NB_IN * DM, W_CIN = W_BOUT + (size_t)DM * DM,
                 W_COUT = W_CIN + (size_t)NC_IN * DM, W_F1 = W_COUT + (size_t)DM * DM, W_F2 = W_F1 + 4ull * NFF2 * DM, W_END = W_F2 + 4ull * DM * DFF;
static_assert(W_END * 2 == 119 * MiB, "weights");
constexpr size_t WS_XN = 122 * MiB;
constexpr size_t WS_AO = 186 * MiB;
constexpr size_t WS_BIG = 250 * MiB;
constexpr size_t WS_LSE = 442 * MiB;
constexpr size_t WS_SS = 444 * MiB;
constexpr size_t WS_WV = 446 * MiB;
constexpr size_t WS_BIAS = 447 * MiB;
constexpr size_t WS_END = 450 * MiB;
constexpr int BIAS_LD = pg8::BIAS_LD;
constexpr int LUTA_P = 132, LUTC_P = 260, LUTC_OFF = 3 * 16 * LUTA_P;
constexpr int LDS_BYTES = 163840;
constexpr int KP = 144;
constexpr int LDS_BARST = LDS_BYTES - 64;
constexpr int LDS_K = 0, LDS_V = 512 * KP, LDS_LUT = 2 * 512 * KP;

struct Args { const float* in[18]; float* out; unsigned char* ws; int lo, hi; };
typedef __attribute__((address_space(4))) const volatile unsigned long long* kargp;
#define GAS __attribute__((address_space(1)))
__device__ __forceinline__ const float* KIN(int i) { return (const float*)(GAS const float*)(((kargp)__builtin_amdgcn_kernarg_segment_ptr())[i]); }
__device__ __forceinline__ float* KOUT() { return (float*)(GAS float*)(((kargp)__builtin_amdgcn_kernarg_segment_ptr())[18]); }
__device__ __forceinline__ unsigned char* KWS() { return (unsigned char*)(GAS unsigned char*)(((kargp)__builtin_amdgcn_kernarg_segment_ptr())[19]); }

__device__ __forceinline__ float wave_sum(float v) {
#pragma unroll
    for (int o = 1; o < 64; o <<= 1) v += __shfl_xor(v, o);
    return v;
}
__device__ __forceinline__ unsigned f2bf(float f) { unsigned u = __builtin_bit_cast(unsigned, f); return (u + 0x7fffu + ((u >> 16) & 1u)) >> 16; }
__device__ __forceinline__ unsigned pk2(float lo, float hi) { return f2bf(lo) | (f2bf(hi) << 16); }
__device__ __forceinline__ float bf_lo(unsigned u) { return __builtin_bit_cast(float, u << 16); }
__device__ __forceinline__ float bf_hi(unsigned u) { return __builtin_bit_cast(float, u & 0xffff0000u); }

template <int MODE>
__device__ __forceinline__ void transpose_item(const float* W, int K, int N, bf16* WT, LAS float* scr, int item, int lane) {
    const int nblk = N / 32, kb = item / nblk, nb = item % nblk, k0 = 64 * kb, n0 = 32 * nb;
    int drow0 = n0;
    if (MODE == 1) { const int s = n0 < DFF ? n0 : n0 - DFF; drow0 = (s >> 7) * 256 + (s & 127) + (n0 < DFF ? 0 : 128); }
#pragma unroll 8
    for (int i = 0; i < 32; ++i) { const int kk = 2 * i + (lane >> 5); scr[kk * 33 + (lane & 31)] = W[(size_t)(k0 + kk) * N + n0 + (lane & 31)]; }
    asm volatile("s_waitcnt lgkmcnt(0)" ::: "memory");
    const int c = lane & 7;
#pragma unroll
    for (int j = 0; j < 4; ++j) { const int n = (lane >> 3) + 8 * j; const LAS float* s = scr + (8 * c) * 33 + n;
        u32x4 o; o.x = pk2(s[0 * 33], s[1 * 33]); o.y = pk2(s[2 * 33], s[3 * 33]); o.z = pk2(s[4 * 33], s[5 * 33]); o.w = pk2(s[6 * 33], s[7 * 33]);
        *(u32x4*)(WT + (size_t)(drow0 + n) * K + k0 + 8 * c) = o; }
    asm volatile("s_waitcnt lgkmcnt(0)" ::: "memory");
}
__device__ __forceinline__ int t5_bucket(int rel) {
    const int n = rel < 0 ? -rel : rel; const float nf = (float)(n > 1 ? n : 1);
    const float v = logf(nf * 0.125f) / 4.852030263919617f * 8.0f;
    int large = 8 + (int)v; large = large < 15 ? large : 15;
    return (rel > 0 ? 16 : 0) + (n < 8 ? n : large);
}
__device__ __forceinline__ void prologue(ldsp lds, int tid, int wave, int lane, int G, int bid) {
    bf16* WT = (bf16*)(KWS() + WS_W);
    LAS float* scr = (LAS float*)(lds + wave * 16384);
    const int gw = bid * NWAVES + wave, NGW = G * NWAVES;
    int it = gw;
#define TR(MODE, src, Kk, Nn, dstoff) { const int cnt = ((Kk) / 64) * ((Nn) / 32); for (; it < cnt; it += NGW) transpose_item<MODE>((src), (Kk), (Nn), WT + (dstoff), scr, it, lane); it -= cnt; }
    TR(0, KIN(8), DM, NA_IN, W_AIN)
    TR(0, KIN(8) + (size_t)DM * NA_IN, DM, NA_IN, W_AIN + (size_t)NA_IN * DM)
    TR(0, KIN(9), DM, DM, W_AOUT)
    TR(0, KIN(9) + (size_t)DM * DM, DM, DM, W_AOUT + (size_t)DM * DM)
    TR(0, KIN(10), DM, NB_IN, W_BIN)
    TR(0, KIN(11), DM, DM, W_BOUT)
    TR(0, KIN(13), DM, NC_IN, W_CIN)
    TR(0, KIN(14), DM, DM, W_COUT)
#pragma unroll 1
    for (int l = 0; l < 4; ++l) TR(1, KIN(16) + (size_t)l * DM * NFF2, DM, NFF2, W_F1 + (size_t)l * NFF2 * DM)
#pragma unroll 1
    for (int l = 0; l < 4; ++l) TR(0, KIN(17) + (size_t)l * DFF * DM, DFF, DM, W_F2 + (size_t)l * DM * DFF)
#undef TR
    { float* lut = (float*)(KWS() + WS_LUT); const float* rb = KIN(2); const int gt = bid * NTHR + tid, NT = G * NTHR;
      for (int i = gt; i < 3 * 16 * 129; i += NT) { const int r = i % 129, h = (i / 129) & 15, g = i / (129 * 16); lut[(g * 16 + h) * LUTA_P + r] = rb[t5_bucket((r - 64) * (1 << (2 * g))) * 16 + h]; }
      for (int i = gt; i < 16 * 257; i += NT) { const int r = i % 257, h = i / 257; lut[LUTC_OFF + h * LUTC_P + r] = rb[t5_bucket(r - 128) * 16 + h]; } }
    __syncthreads();
    LAS float* sc = (LAS float*)lds; LAS float* red = (LAS float*)(lds + 32768);
    for (int i = tid; i < NB * DM; i += NTHR) { const float v = KIN(1)[i]; sc[i] = v / (1.0f + __expf(-v)); }
    __syncthreads();
    float* mod = (float*)(KWS() + WS_MOD);
    for (int unit = bid; unit < 4 * 96; unit += G) {
        const int l = unit / 96, cb = unit % 96;
        const float* wp = KIN(3) + (size_t)l * DM * 6144 + (size_t)(wave * 128) * 6144 + cb * 64 + lane;
        float acc[8];
#pragma unroll
        for (int b = 0; b < 8; ++b) acc[b] = 0.f;
#pragma unroll 4
        for (int k = 0; k < 128; ++k) { const float wv = wp[(size_t)k * 6144];
#pragma unroll
            for (int b = 0; b < 8; ++b) acc[b] += sc[b * DM + wave * 128 + k] * wv; }
#pragma unroll
        for (int b = 0; b < 8; ++b) red[(wave * 8 + b) * 64 + lane] = acc[b];
        __syncthreads();
        { const int b = tid >> 6; float s = KIN(4)[l * 6144 + cb * 64 + lane];
#pragma unroll
          for (int w = 0; w < 8; ++w) s += red[(w * 8 + b) * 64 + lane];
          mod[(size_t)(l * 8 + b) * 6144 + cb * 64 + lane] = s; }
        __syncthreads();
    }
}

__device__ __forceinline__ void norm0_phase(int tid, int wave, int lane, int G, int bid) {
    const float* mod = (const float*)(KWS() + WS_MOD);
    const int gw = bid * NWAVES + wave, NGW = G * NWAVES;
    { float* wv = (float*)(KWS() + WS_WV); const int gt = bid * NTHR + tid, NT = G * NTHR;
      for (int i = gt; i < 9 * 8 * 1024; i += NT) { const int k = i & 1023, b = (i >> 10) & 7, idx = i >> 13; float v;
          if (idx == 8) v = KIN(7)[k]; else { const int l = idx >> 1, wh = idx & 1; const float g = (wh ? KIN(6) : KIN(5))[l * 1024 + k]; v = g * (1.0f + mod[(size_t)(l * 8 + b) * 6144 + (wh ? 4096 : 1024) + k]); }
          wv[i] = v; } }
#pragma unroll 1
    for (int gi = 0; gi < 8; ++gi) {
        const int l = gi >> 1, wh = gi & 1, mk = l % 3, mj = l / 3;
        const int N = wh ? NFF2 : (mk == 0 ? NA_IN : (mk == 1 ? NB_IN : NC_IN));
        const bf16* wt = (const bf16*)(KWS() + WS_W) + (wh ? W_F1 + (size_t)l * NFF2 * DM : (mk == 0 ? W_AIN + (size_t)mj * NA_IN * DM : (mk == 1 ? W_BIN : W_CIN)));
        float sh[8][16];
#pragma unroll
        for (int b = 0; b < 8; ++b)
#pragma unroll
            for (int h = 0; h < 2; ++h) { const float* sp = mod + (size_t)(l * 8 + b) * 6144 + (wh ? 3072 : 0) + h * 512 + 8 * lane; const f32x4 a0 = *(const f32x4*)sp, a1 = *(const f32x4*)(sp + 4);
                sh[b][h * 8 + 0] = a0[0]; sh[b][h * 8 + 1] = a0[1]; sh[b][h * 8 + 2] = a0[2]; sh[b][h * 8 + 3] = a0[3]; sh[b][h * 8 + 4] = a1[0]; sh[b][h * 8 + 5] = a1[1]; sh[b][h * 8 + 6] = a1[2]; sh[b][h * 8 + 7] = a1[3]; }
        float* bias = (float*)(KWS() + WS_BIAS) + (size_t)gi * 8 * BIAS_LD;
        for (int n = gw; n < N; n += NGW) {
            const u32x4 w0 = *(const u32x4*)(wt + (size_t)n * DM + 8 * lane), w1 = *(const u32x4*)(wt + (size_t)n * DM + 512 + 8 * lane);
            float wf[16];
#pragma unroll
            for (int j = 0; j < 4; ++j) { wf[2 * j] = bf_lo(w0[j]); wf[2 * j + 1] = bf_hi(w0[j]); wf[8 + 2 * j] = bf_lo(w1[j]); wf[8 + 2 * j + 1] = bf_hi(w1[j]); }
            float mine = 0.f;
#pragma unroll
            for (int b = 0; b < 8; ++b) { float t = 0.f;
#pragma unroll
                for (int j = 0; j < 16; ++j) t += sh[b][j] * wf[j];
                t = wave_sum(t); mine = (lane == b) ? t : mine; }
            if (lane < 8) bias[(size_t)lane * BIAS_LD + n] = mine;
        }
    }
    { const float* x = KIN(0); bf16* xn = (bf16*)(KWS() + WS_XN); float* ss = (float*)(KWS() + WS_SS);
      f32x4 gv[4];
#pragma unroll
      for (int j = 0; j < 4; ++j) gv[j] = *(const f32x4*)(KIN(5) + 4 * (lane + 64 * j));
      for (int m = gw; m < MTOK; m += NGW) {
        const f32x4* xr = (const f32x4*)(x + (size_t)m * DM) + lane;
        f32x4 v[4]; float s = 0.f;
#pragma unroll
        for (int j = 0; j < 4; ++j) { v[j] = xr[64 * j]; s += (v[j].x * v[j].x + v[j].y * v[j].y) + (v[j].z * v[j].z + v[j].w * v[j].w); }
        s = wave_sum(s); if (lane == 0) ss[m] = s;
        const int b = m >> 12; u32x2* o8 = (u32x2*)(xn + (size_t)m * DM) + lane;
#pragma unroll
        for (int j = 0; j < 4; ++j) { const f32x4 scl = *(const f32x4*)(mod + (size_t)b * 6144 + 1024 + 4 * (lane + 64 * j));
            const f32x4 y = v[j] * gv[j] * (scl + 1.0f); u32x2 w; w.x = pk2(y.x, y.y); w.y = pk2(y.z, y.w); o8[64 * j] = w; }
      } }
}
__device__ __forceinline__ void fin_phase(int wave, int lane, int G, int bid) {
    const int gw = bid * NWAVES + wave, NGW = G * NWAVES;
    float* out = KOUT(); const float* ss = (const float*)(KWS() + WS_SS) + (size_t)8 * MTOK;
    f32x4 gv[4];
#pragma unroll
    for (int j = 0; j < 4; ++j) gv[j] = *(const f32x4*)(KIN(7) + 4 * (lane + 64 * j));
    for (int m = gw; m < MTOK; m += NGW) {
        f32x4* xr = (f32x4*)(out + (size_t)m * DM) + lane; const float rstd = 1.0f / sqrtf(ss[m] * (1.0f / DM) + 1e-6f);
#pragma unroll
        for (int j = 0; j < 4; ++j) xr[64 * j] = (xr[64 * j] * rstd) * gv[j];
    }
}

__device__ __forceinline__ s16x4 vtr(ldscp p) { return __builtin_bit_cast(s16x4, __builtin_amdgcn_ds_read_tr16_b64_v4i16((LAS s16x4*)p)); }
__device__ __forceinline__ unsigned cvtpk(float lo, float hi) { unsigned r; asm volatile("v_cvt_pk_bf16_f32 %0, %1, %2" : "=v"(r) : "v"(lo), "v"(hi)); return r; }

template <int KIND, int NCH, int VP = KP>
__device__ __forceinline__ void attn_wave(ldscp Ks, ldscp Vs, const LAS float* lut, const LAS float* pen, bf16x8 q0, bf16x8 q1, int krow0, int p0, int p1, int p2, int p3, float sinkv,
                                          f32x4 (&O)[4], float& mo, float& lo, int lane) {
    constexpr int RS = (KIND == 1) ? 64 : 32;
    const int i16 = lane & 15, G = lane >> 4;
    f32x4 S[NCH][2];
    const int slot0 = (KIND == 1) ? (int)sinkv : (KIND == 2 ? p1 : 0);
#define ATT_ROWOFF(ch) ((KIND != 0) ? ((slot0 + (ch) >= 9 ? slot0 + (ch) - 9 : slot0 + (ch)) * RS) : RS * (ch))
    { ldscp kp = Ks + (krow0 + 8 * (i16 >> 2) + (i16 & 3)) * KP + 16 * G;
#pragma unroll
      for (int ch = 0; ch < NCH; ++ch)
#pragma unroll
        for (int s = 0; s < 2; ++s) { const bf16x8 k0 = *(const LAS bf16x8*)(kp + (ATT_ROWOFF(ch) + 4 * s) * KP), k1 = *(const LAS bf16x8*)(kp + (ATT_ROWOFF(ch) + 4 * s) * KP + 64);
            f32x4 acc = (f32x4){0.f, 0.f, 0.f, 0.f};
            acc = __builtin_amdgcn_mfma_f32_16x16x32_bf16(k0, q0, acc, 0, 0, 0);
            acc = __builtin_amdgcn_mfma_f32_16x16x32_bf16(k1, q1, acc, 0, 0, 0);
            S[ch][s] = acc; } }
    float mx = -1e30f;
    if (KIND != 1) {
        const LAS float* lp = lut + (krow0 - p0 + 8 * G); const LAS float* pp = pen + (krow0 + 8 * G);
#pragma unroll
        for (int ch = 0; ch < NCH; ++ch)
#pragma unroll
            for (int s = 0; s < 2; ++s) { const f32x4 pn = *(const LAS f32x4*)(pp + ATT_ROWOFF(ch) + 4 * s);
#pragma unroll
                for (int e = 0; e < 4; ++e) { const float v = (S[ch][s][e] * 0.125f + lp[32 * ch + 4 * s + e]) + pn[e]; S[ch][s][e] = v; mx = fmaxf(mx, v); } }
    } else
#pragma unroll
    for (int ch = 0; ch < NCH; ++ch) {
#pragma unroll
        for (int s = 0; s < 2; ++s)
#pragma unroll
            for (int e = 0; e < 4; ++e) { const int kc = 8 * G + 4 * s + e; bool ok; float bv;
                const int col = p3 + kc, idx = col - p0 + 15; ok = (unsigned)(col - p1) < 16u; const int ic = idx < 0 ? 0 : (idx > 30 ? 30 : idx); bv = lut[(ch + p2) * 31 + ic];
                const float v = (S[ch][s][e] * 0.125f + bv) + (ok ? 0.f : -1e30f); S[ch][s][e] = v; mx = fmaxf(mx, v); }
    }
    mx = fmaxf(mx, __shfl_xor(mx, 16)); mx = fmaxf(mx, __shfl_xor(mx, 32));
    float sum = 0.f;
#pragma unroll
    for (int ch = 0; ch < NCH; ++ch)
#pragma unroll
        for (int s = 0; s < 2; ++s)
#pragma unroll
            for (int e = 0; e < 4; ++e) { const float p = __builtin_amdgcn_exp2f((S[ch][s][e] - mx) * 1.44269504089f); S[ch][s][e] = p; sum += p; }
    sum += __shfl_xor(sum, 16); sum += __shfl_xor(sum, 32);
    if (KIND == 2) sum += __builtin_amdgcn_exp2f((sinkv - mx) * 1.44269504089f);
#pragma unroll
    for (int db = 0; db < 4; ++db) O[db] = (f32x4){0.f, 0.f, 0.f, 0.f};
    { ldscp vp = Vs + (krow0 + 8 * G + (i16 >> 2)) * VP + 8 * (i16 & 3);
#pragma unroll
      for (int ch = 0; ch < NCH; ++ch) {
        u32x4 pw; pw.x = cvtpk(S[ch][0][0], S[ch][0][1]); pw.y = cvtpk(S[ch][0][2], S[ch][0][3]); pw.z = cvtpk(S[ch][1][0], S[ch][1][1]); pw.w = cvtpk(S[ch][1][2], S[ch][1][3]);
        const bf16x8 pb = __builtin_bit_cast(bf16x8, pw);
#pragma unroll
        for (int db = 0; db < 4; ++db) { const s16x4 vl = vtr(vp + ATT_ROWOFF(ch) * VP + 32 * db), vh = vtr(vp + (ATT_ROWOFF(ch) + 4) * VP + 32 * db);
            const bf16x8 va = (bf16x8){vl[0], vl[1], vl[2], vl[3], vh[0], vh[1], vh[2], vh[3]};
            O[db] = __builtin_amdgcn_mfma_f32_16x16x32_bf16(va, pb, O[db], 0, 0, 0); } } }
    mo = mx; lo = sum;
#undef ATT_ROWOFF
}
__device__ __forceinline__ float xmax16(float v) { auto r = __builtin_amdgcn_permlane16_swap(__builtin_bit_cast(unsigned, v), __builtin_bit_cast(unsigned, v), false, false); return fmaxf(__builtin_bit_cast(float, r[0]), __builtin_bit_cast(float, r[1])); }
__device__ __forceinline__ float xmax32(float v) { auto r = __builtin_amdgcn_permlane32_swap(__builtin_bit_cast(unsigned, v), __builtin_bit_cast(unsigned, v), false, false); return fmaxf(__builtin_bit_cast(float, r[0]), __builtin_bit_cast(float, r[1])); }
__device__ __forceinline__ float xadd16(float v) { auto r = __builtin_amdgcn_permlane16_swap(__builtin_bit_cast(unsigned, v), __builtin_bit_cast(unsigned, v), false, false); return __builtin_bit_cast(float, r[0]) + __builtin_bit_cast(float, r[1]); }
__device__ __forceinline__ float xadd32(float v) { auto r = __builtin_amdgcn_permlane32_swap(__builtin_bit_cast(unsigned, v), __builtin_bit_cast(unsigned, v), false, false); return __builtin_bit_cast(float, r[0]) + __builtin_bit_cast(float, r[1]); }
template <int NCH>
__device__ __forceinline__ void attn_wave_dual(ldscp Ks, ldscp Vs, const LAS float* lut, const LAS float* pen, const bf16x8 (&q)[2][2], int krow0a, int krow0b, int p0a, int p0b,
                                               f32x4 (&O)[2][4], float (&mo)[2], float (&lo)[2], int lane) {
    const int i16 = lane & 15, G = lane >> 4;
    f32x4 S[2][NCH][2];
    ldscp kp[2]; kp[0] = Ks + (krow0a + 8 * (i16 >> 2) + (i16 & 3)) * KP + 16 * G; kp[1] = Ks + (krow0b + 8 * (i16 >> 2) + (i16 & 3)) * KP + 16 * G;
#pragma unroll
    for (int ch = 0; ch < NCH; ++ch)
#pragma unroll
        for (int s = 0; s < 2; ++s)
#pragma unroll
            for (int t = 0; t < 2; ++t) { const bf16x8 k0 = *(const LAS bf16x8*)(kp[t] + (32 * ch + 4 * s) * KP), k1 = *(const LAS bf16x8*)(kp[t] + (32 * ch + 4 * s) * KP + 64);
                f32x4 acc = (f32x4){0.f, 0.f, 0.f, 0.f};
                acc = __builtin_amdgcn_mfma_f32_16x16x32_bf16(k0, q[t][0], acc, 0, 0, 0);
                acc = __builtin_amdgcn_mfma_f32_16x16x32_bf16(k1, q[t][1], acc, 0, 0, 0);
                S[t][ch][s] = acc; }
    float mx[2] = {-1e30f, -1e30f};
    const LAS float* lp[2]; lp[0] = lut + (krow0a - p0a + 8 * G); lp[1] = lut + (krow0b - p0b + 8 * G);
    const LAS float* pp[2]; pp[0] = pen + (krow0a + 8 * G); pp[1] = pen + (krow0b + 8 * G);
#pragma unroll
    for (int ch = 0; ch < NCH; ++ch)
#pragma unroll
        for (int s = 0; s < 2; ++s)
#pragma unroll
            for (int t = 0; t < 2; ++t) { const f32x4 pn = *(const LAS f32x4*)(pp[t] + 32 * ch + 4 * s);
#pragma unroll
                for (int e = 0; e < 4; ++e) { const float v = (S[t][ch][s][e] * 0.125f + lp[t][32 * ch + 4 * s + e]) + pn[e]; S[t][ch][s][e] = v; mx[t] = fmaxf(mx[t], v); } }
#pragma unroll
    for (int t = 0; t < 2; ++t) { mx[t] = fmaxf(mx[t], __shfl_xor(mx[t], 16)); mx[t] = fmaxf(mx[t], __shfl_xor(mx[t], 32)); }
    float sum[2] = {0.f, 0.f};
#pragma unroll
    for (int ch = 0; ch < NCH; ++ch)
#pragma unroll
        for (int s = 0; s < 2; ++s)
#pragma unroll
            for (int t = 0; t < 2; ++t)
#pragma unroll
                for (int e = 0; e < 4; ++e) { const float p = __builtin_amdgcn_exp2f((S[t][ch][s][e] - mx[t]) * 1.44269504089f); S[t][ch][s][e] = p; sum[t] += p; }
#pragma unroll
    for (int t = 0; t < 2; ++t) { sum[t] += __shfl_xor(sum[t], 16); sum[t] += __shfl_xor(sum[t], 32); }
#pragma unroll
    for (int t = 0; t < 2; ++t)
#pragma unroll
        for (int db = 0; db < 4; ++db) O[t][db] = (f32x4){0.f, 0.f, 0.f, 0.f};
    ldscp vp[2]; vp[0] = Vs + (krow0a + 8 * G + (i16 >> 2)) * KP + 8 * (i16 & 3); vp[1] = Vs + (krow0b + 8 * G + (i16 >> 2)) * KP + 8 * (i16 & 3);
#pragma unroll
    for (int ch = 0; ch < NCH; ++ch) {
        bf16x8 pb[2];
#pragma unroll
        for (int t = 0; t < 2; ++t) { u32x4 pw; pw.x = cvtpk(S[t][ch][0][0], S[t][ch][0][1]); pw.y = cvtpk(S[t][ch][0][2], S[t][ch][0][3]); pw.z = cvtpk(S[t][ch][1][0], S[t][ch][1][1]); pw.w = cvtpk(S[t][ch][1][2], S[t][ch][1][3]);
            pb[t] = __builtin_bit_cast(bf16x8, pw); }
#pragma unroll
        for (int db = 0; db < 4; ++db)
#pragma unroll
            for (int t = 0; t < 2; ++t) { const s16x4 vl = vtr(vp[t] + (32 * ch) * KP + 32 * db), vh = vtr(vp[t] + (32 * ch + 4) * KP + 32 * db);
                const bf16x8 va = (bf16x8){vl[0], vl[1], vl[2], vl[3], vh[0], vh[1], vh[2], vh[3]};
                O[t][db] = __builtin_amdgcn_mfma_f32_16x16x32_bf16(va, pb[t], O[t][db], 0, 0, 0); } }
#pragma unroll
    for (int t = 0; t < 2; ++t) { mo[t] = mx[t]; lo[t] = sum[t]; }
}
__device__ __forceinline__ void attn_store(bf16* orow, const f32x4 (&O)[4], float inv, int lane) {
    const int G = lane >> 4;
#pragma unroll
    for (int db = 0; db < 4; ++db) { u32x2 w; w.x = cvtpk(O[db][0] * inv, O[db][1] * inv); w.y = cvtpk(O[db][2] * inv, O[db][3] * inv); *(u32x2*)(orow + 16 * db + 4 * G) = w; }
}

#define LSE_IDX(qr, hd) ((((qr) >> 12) * 16 + (hd)) * (size_t)SEQ + ((qr) & (SEQ - 1)))
__device__ __forceinline__ void attnA_phase(const bf16* qkv, bf16* ao, float* lse, const float* lutA, int g, int half, ldsp lds, int tid, int wave, int lane, int G, int bid) {
    const int i16 = lane & 15, Gq = lane >> 4; constexpr int NU = (NB / 2) * 16 * 16;
    const int dsh = 2 * g, L = SEQ >> dsh, lb = 4 - dsh; ao += (size_t)half * (MTOK / 2) * DM; lse += (size_t)half * (MTOK / 2) * 16;
    u32x4 kr[6], vr[6]; bf16x8 qa0 = (bf16x8){0, 0, 0, 0, 0, 0, 0, 0}, qa1 = qa0, qb0 = qa0, qb1 = qa0; float lutv = 0.f; unsigned vmask = 0u;
#define A_DECODE(uu) const int rb = (uu) & 15; const int head = ((uu) >> 4) & 15, bl = (uu) >> 8; \
        const int res = rb >> lb, j0 = (rb & ((1 << lb) - 1)) * 256; \
        const int qi = 32 * wave + i16, toka = ((j0 + qi) << dsh) + res, tokb = ((j0 + 16 + qi) << dsh) + res, lsb = (bl * 16 + head) * SEQ; const size_t qrowa = (size_t)bl * SEQ + toka, qrowb = (size_t)bl * SEQ + tokb;
#define A_PREFETCH(uu) { A_DECODE(uu) const bf16* base = qkv + (size_t)bl * SEQ * NG_IN + head * 64; \
        _Pragma("unroll") for (int itx = 0; itx < 6; ++itx) { const int p_ = tid + NTHR * itx, row = p_ >> 3, pc = p_ & 7, j = j0 - 64 + row; const bool valid = (j >= 0) && (j < L); \
            kr[itx] = (u32x4){0u, 0u, 0u, 0u}; vr[itx] = kr[itx]; vmask = itx == 0 ? (valid ? 1u : 0u) : (vmask | (valid ? (1u << itx) : 0u)); \
            if (valid) { const bf16* rp = base + (size_t)((j << dsh) + res) * NG_IN + pc * 8; kr[itx] = *(const u32x4*)(rp + 1024); vr[itx] = *(const u32x4*)(rp + 2048); } } \
        lutv = (tid >= 127 && tid < 256) ? lutA[(g * 16 + head) * LUTA_P + tid - 127] : -1e30f; \
        const bf16* qp = qkv + qrowa * NG_IN + head * 64 + 8 * Gq; qa0 = *(const bf16x8*)qp; qa1 = *(const bf16x8*)(qp + 32); \
        const bf16* qp2 = qkv + qrowb * NG_IN + head * 64 + 8 * Gq; qb0 = *(const bf16x8*)qp2; qb1 = *(const bf16x8*)(qp2 + 32); }
    int u = (G & 7) ? bid : (bid & 7) * (G >> 3) + (bid >> 3);
    if (u < NU) A_PREFETCH(u)
    for (; u < NU; u += G) {
        __syncthreads();
#pragma unroll
        for (int itx = 0; itx < 6; ++itx) { const int p_ = tid + NTHR * itx, row = p_ >> 3, pc = p_ & 7; *(LAS u32x4*)(lds + LDS_K + row * KP + pc * 16) = kr[itx]; *(LAS u32x4*)(lds + LDS_V + row * KP + pc * 16) = vr[itx];
            if (pc == 0) ((LAS float*)(lds + LDS_LUT + 2048))[row] = ((vmask >> itx) & 1u) ? 0.f : -1e30f; }
        if (tid < 384) ((LAS float*)(lds + LDS_LUT))[tid] = lutv;
        const bf16x8 ca0 = qa0, ca1 = qa1, cb0 = qb0, cb1 = qb1;
        __syncthreads();
        if (u + G < NU) A_PREFETCH(u + G)
        A_DECODE(u)
        u32x2 po[2][4]; float pl[2] = {0.f, 0.f};
        if (g > 0) {
#pragma unroll
            for (int ps = 0; ps < 2; ++ps) { const size_t qrow = ps ? qrowb : qrowa; pl[ps] = lse[lsb + (ps ? tokb : toka)];
#pragma unroll
                for (int db = 0; db < 4; ++db) po[ps][db] = *(const u32x2*)(ao + qrow * DM + head * 64 + 16 * db + 4 * Gq); } }
        { f32x4 O[2][4]; float mo[2], lo[2]; const bf16x8 qq[2][2] = {{ca0, ca1}, {cb0, cb1}};
          attn_wave_dual<5>(lds + LDS_K, lds + LDS_V, (const LAS float*)(lds + LDS_LUT) + 127, (const LAS float*)(lds + LDS_LUT + 2048), qq, 32 * wave, 32 * wave, qi, 16 + qi, O, mo, lo, lane);
#pragma unroll
          for (int ps = 0; ps < 2; ++ps) { const size_t qrow = ps ? qrowb : qrowa;
            const float ln = mo[ps] + logf(lo[ps]); float wn = 1.0f / lo[ps], wo = 0.f, lt = ln;
            if (g > 0) { const float mm = fmaxf(ln, pl[ps]), en = __expf(ln - mm), eo = __expf(pl[ps] - mm), inv = 1.0f / (en + eo); wn *= en * inv; wo = eo * inv; lt = mm + logf(en + eo);
#pragma unroll
                for (int db = 0; db < 4; ++db) { O[ps][db][0] = O[ps][db][0] * wn + wo * bf_lo(po[ps][db].x); O[ps][db][1] = O[ps][db][1] * wn + wo * bf_hi(po[ps][db].x);
                    O[ps][db][2] = O[ps][db][2] * wn + wo * bf_lo(po[ps][db].y); O[ps][db][3] = O[ps][db][3] * wn + wo * bf_hi(po[ps][db].y); }
                wn = 1.0f; }
            attn_store(ao + qrow * DM + head * 64, O[ps], wn, lane);
            if (Gq == 0) lse[lsb + (ps ? tokb : toka)] = lt; } }
    }
#undef A_DECODE
#undef A_PREFETCH
}
__device__ __forceinline__ void attnC_phase(const bf16* qkv, bf16* ao, const float* lutC, const float* sink, ldsp lds, int tid, int wave, int lane, int G, int bid) {
    const int i16 = lane & 15, Gq = lane >> 4;
    constexpr int LDS_LUTC = 120064, LDS_PENC = LDS_LUTC + 20480;
    for (int i_ = tid; i_ < 16 * 320; i_ += NTHR) { const int h_ = i_ / 320, idx = i_ % 320 - 31; ((LAS float*)(lds + LDS_LUTC))[i_] = (idx >= 0 && idx <= 256) ? lutC[h_ * LUTC_P + idx] : -1e30f; }
    const int hh = wave & 3, qs = wave >> 2, qi = 16 * qs + i16;
    const int prow = (tid >> 3) & 31, ppc = tid & 7; const bool isv = tid >= 256;
    for (int it = (G & 7) ? bid : (bid & 7) * (G >> 3) + (bid >> 3); it < NB * 4 * 8; it += G) {
        const int seg = it & 7, hkv = (it >> 3) & 3, b = it >> 5, qb0 = 16 * seg, hq = hkv * 4 + hh;
        const bf16* base = qkv + (size_t)b * SEQ * NC_IN + 1024 + hkv * 64 + (isv ? 256 : 0) + ppc * 8;
        const float sk = sink[hq];
        __syncthreads();
        for (int ch = 0; ch < 9; ++ch) { const int cidx = qb0 - 4 + ch, pos = 32 * cidx + prow, sl = (cidx + 9) % 9; const bool valid = (pos >= 0) && (pos < SEQ);
            u32x4 d = (u32x4){0u, 0u, 0u, 0u}; if (valid) d = *(const u32x4*)(base + (size_t)pos * NC_IN);
            *(LAS u32x4*)(lds + (isv ? LDS_V : LDS_K) + (sl * 32 + prow) * KP + ppc * 16) = d;
            if (tid < 32) ((LAS float*)(lds + LDS_PENC))[sl * 32 + tid] = (32 * cidx + tid >= 0 && 32 * cidx + tid < SEQ) ? 0.f : -1e30f; }
        bf16x8 q0, q1;
        { const size_t qrow = (size_t)b * SEQ + 32 * qb0 + qi; const bf16* qp = qkv + qrow * NC_IN + hq * 64 + 8 * Gq; q0 = *(const bf16x8*)qp; q1 = *(const bf16x8*)(qp + 32); }
        u32x4 nd = (u32x4){0u, 0u, 0u, 0u};
        for (int st = 0; st < 16; ++st) {
            const int qb = qb0 + st;
            if (st > 0) { __syncthreads();
                const int cidx = qb + 4, sl = (cidx + 9) % 9;
                *(LAS u32x4*)(lds + (isv ? LDS_V : LDS_K) + (sl * 32 + prow) * KP + ppc * 16) = nd;
                if (tid < 32) ((LAS float*)(lds + LDS_PENC))[sl * 32 + tid] = (32 * cidx + tid < SEQ) ? 0.f : -1e30f; }
            const bf16x8 cq0 = q0, cq1 = q1;
            __syncthreads();
            if (st < 15) { const int pos = 32 * (qb + 5) + prow; nd = (u32x4){0u, 0u, 0u, 0u}; if (pos < SEQ) nd = *(const u32x4*)(base + (size_t)pos * NC_IN);
                const size_t qrow2 = (size_t)b * SEQ + 32 * (qb + 1) + qi; const bf16* qp = qkv + qrow2 * NC_IN + hq * 64 + 8 * Gq; q0 = *(const bf16x8*)qp; q1 = *(const bf16x8*)(qp + 32); }
            f32x4 O[4]; float mo, lo;
            attn_wave<2, 9>(lds + LDS_K, lds + LDS_V, (const LAS float*)(lds + LDS_LUTC) + hq * 320 + 31, (const LAS float*)(lds + LDS_PENC), cq0, cq1, 0, qi, (qb + 5) % 9, 0, 0, sk, O, mo, lo, lane);
            const size_t qrow = (size_t)b * SEQ + 32 * qb + qi;
            attn_store(ao + qrow * DM + hq * 64, O, 1.0f / lo, lane);
        }
    }
}
__device__ __forceinline__ void attnB_phase(const bf16* qkv, bf16* ao, const float* rpb, ldsp lds, int tid, int wave, int lane, int G, int bid) {
    constexpr int BK_OFF = 0, BV_OFF = 576 * KP, BVP = 128, BLUT_OFF = BV_OFF + 576 * BVP;
    const int i16 = lane & 15, Gq = lane >> 4, qs = wave & 3, wrow = wave >> 2, c = 16 * qs + i16;
    int cs = c - 8; cs = cs < 0 ? 0 : (cs > 48 ? 48 : cs);
    const int cw0 = qs == 0 ? 0 : (qs == 1 ? 8 : (qs == 2 ? 24 : 32));
    const int prow = tid >> 3, ppc = tid & 7;
    for (int it = (G & 7) ? bid : (bid & 7) * (G >> 3) + (bid >> 3); it < NB * 16 * 2; it += G) {
        const int half = it & 1, head = (it >> 1) & 15, b = it >> 5, rbase = 32 * half;
        const bf16* kbase = qkv + (size_t)b * SEQ * NB_IN + 1024 + head * 64 + ppc * 8;
        __syncthreads();
        if (tid < 465) ((LAS float*)(lds + BLUT_OFF))[tid] = rpb[head * 465 + tid];
        int hi;
        { int r0s = rbase - 4; r0s = r0s < 0 ? 0 : (r0s > 56 ? 56 : r0s); int r1s = rbase + 1 - 4; r1s = r1s < 0 ? 0 : (r1s > 56 ? 56 : r1s); hi = r1s + 7;
          for (int R = r0s; R <= hi; ++R) { const bf16* rp = kbase + (size_t)(64 * R + prow) * NB_IN; const u32x4 kv = *(const u32x4*)rp, vv = *(const u32x4*)(rp + 1024); const int sl = R % 9;
              *(LAS u32x4*)(lds + BK_OFF + (sl * 64 + prow) * KP + ppc * 16) = kv; *(LAS u32x4*)(lds + BV_OFF + (sl * 64 + prow) * BVP + ppc * 16) = vv; } }
        bf16x8 q0, q1;
        { const size_t qrow = (size_t)b * SEQ + (rbase + wrow) * 64 + c; const bf16* qp = qkv + qrow * NB_IN + head * 64 + 8 * Gq; q0 = *(const bf16x8*)qp; q1 = *(const bf16x8*)(qp + 32); }
        u32x4 nk[2], nv[2]; int nnew = 0;
        for (int st = 0; st < 16; ++st) {
            const int r = rbase + 2 * st + wrow; int rs = r - 4; rs = rs < 0 ? 0 : (rs > 56 ? 56 : rs);
            if (st > 0) { __syncthreads();
#pragma unroll
                for (int k = 0; k < 2; ++k) if (k < nnew) { const int sl = (hi + 1 + k) % 9;
                    *(LAS u32x4*)(lds + BK_OFF + (sl * 64 + prow) * KP + ppc * 16) = nk[k]; *(LAS u32x4*)(lds + BV_OFF + (sl * 64 + prow) * BVP + ppc * 16) = nv[k]; }
                hi += nnew; }
            const bf16x8 cq0 = q0, cq1 = q1;
            __syncthreads();
            nnew = 0;
            if (st < 15) {
                int r1n = rbase + 2 * st + 3 - 4; r1n = r1n < 0 ? 0 : (r1n > 56 ? 56 : r1n); nnew = r1n + 7 - hi;
#pragma unroll
                for (int k = 0; k < 2; ++k) if (k < nnew) { const bf16* rp = kbase + (size_t)(64 * (hi + 1 + k) + prow) * NB_IN; nk[k] = *(const u32x4*)rp; nv[k] = *(const u32x4*)(rp + 1024); }
                const size_t qrow2 = (size_t)b * SEQ + (r + 2) * 64 + c; const bf16* qp = qkv + qrow2 * NB_IN + head * 64 + 8 * Gq; q0 = *(const bf16x8*)qp; q1 = *(const bf16x8*)(qp + 32);
            }
            f32x4 O[4]; float mo, lo;
            attn_wave<1, 8, BVP>(lds + BK_OFF, lds + BV_OFF, (const LAS float*)(lds + BLUT_OFF), (const LAS float*)(lds + BLUT_OFF), cq0, cq1, cw0, c, cs, rs - r + 7, cw0, (float)(rs % 9), O, mo, lo, lane);
            const size_t qrow = (size_t)b * SEQ + r * 64 + c;
            attn_store(ao + qrow * DM + head * 64, O, 1.0f / lo, lane);
        }
    }
}

#define XB_TMO      128
#define XB_XCNT(j)  (256  + 64 * (j))
#define XB_XSUB(j)  (1280 + 64 * (j))
#define XB_XGEN(j)  (2304 + 64 * (j))
#define XB_TOP      3328
#define XB_TOPGEN   3392
#define XCD_BAR_WORDS 3456
#define XB_SPIN_CAP (1u << 18)

__device__ __forceinline__ unsigned xb_ld(unsigned* p)              { return __hip_atomic_load(p, __ATOMIC_RELAXED, __HIP_MEMORY_SCOPE_AGENT); }
__device__ __forceinline__ unsigned xb_add(unsigned* p, unsigned v) { return __hip_atomic_fetch_add(p, v, __ATOMIC_RELAXED, __HIP_MEMORY_SCOPE_AGENT); }
__device__ __forceinline__ unsigned xb_xcc_id() { return (unsigned)__builtin_amdgcn_s_getreg((3 << 11) | 20) & 0xFu; }
#define XB_SPIN(cond, bar) do { unsigned _sp = 0; while (cond) { __builtin_amdgcn_s_sleep(1); \
    if ((++_sp & 255u) == 0u) { if (xb_ld(&(bar)[XB_TMO])) break; if (_sp > XB_SPIN_CAP) { atomicAdd(&(bar)[XB_TMO], 1u); break; } } } } while (0)

struct XcdBarrier {
    unsigned* bar; unsigned x;
    volatile LAS unsigned* st;
};

__device__ __forceinline__ XcdBarrier xcd_barrier_post(unsigned* bar, volatile LAS unsigned* st) {
    XcdBarrier b; b.bar = bar; b.x = xb_xcc_id(); b.st = st;
    if (threadIdx.x == 0) (void)xb_add(&bar[XB_XCNT(b.x)], 1u);
    return b;
}
__device__ __forceinline__ void xcd_barrier_complete(unsigned* bar, unsigned x, unsigned& nloc, unsigned& nx) {
    const unsigned G = gridDim.x * gridDim.y * gridDim.z;
    unsigned sum, cnt, mine, sp = 0u;
    for (;;) {
        sum = 0u; cnt = 0u; mine = 0u;
#pragma unroll
        for (unsigned j = 0; j < 16; ++j) { const unsigned c = xb_ld(&bar[XB_XCNT(j)]); sum += c; cnt += (c > 0u) ? 1u : 0u; mine = (j == x) ? c : mine; }
        if (sum == G) break;
        __builtin_amdgcn_s_sleep(1);
        if ((++sp & 255u) == 0u) { if (xb_ld(&bar[XB_TMO])) break; if (sp > XB_SPIN_CAP) { atomicAdd(&bar[XB_TMO], 1u); break; } }
    }
    nloc = mine > 0u ? mine : 1u; nx = cnt > 0u ? cnt : 1u;
}

__device__ __forceinline__ void xcd_barrier(const XcdBarrier& b) {
    asm volatile("s_waitcnt vmcnt(0)" ::: "memory");
    __syncthreads();
    if (threadIdx.x == 0) {
        unsigned* bar = b.bar;
        __builtin_amdgcn_s_waitcnt(0);
        unsigned nloc = b.st[0], nx = b.st[1];
        if (nloc == 0u) { xcd_barrier_complete(bar, b.x, nloc, nx); b.st[0] = nloc; b.st[1] = nx; }
        const unsigned old = xb_add(&bar[XB_XSUB(b.x)], 1u);
        const unsigned gen = old / nloc;
        if (old + 1u == (gen + 1u) * nloc) {
            __builtin_amdgcn_fence(__ATOMIC_RELEASE, "agent");
            asm volatile("s_waitcnt vmcnt(0)" ::: "memory");
            const unsigned og = xb_add(&bar[XB_TOP], 1u);
            const unsigned tg = og / nx;
            if (og + 1u == (tg + 1u) * nx) xb_add(&bar[XB_TOPGEN], 1u);
            else XB_SPIN(xb_ld(&bar[XB_TOPGEN]) == tg, bar);
            __builtin_amdgcn_fence(__ATOMIC_ACQUIRE, "agent");
            xb_add(&bar[XB_XGEN(b.x)], 1u);
            asm volatile("s_waitcnt vmcnt(0)" ::: "memory");
        } else {
            XB_SPIN(xb_ld(&bar[XB_XGEN(b.x)]) == gen, bar);
            __builtin_amdgcn_fence(__ATOMIC_ACQUIRE, "agent");
            asm volatile("s_waitcnt vmcnt(0)" ::: "memory");
        }
    }
    __syncthreads();
}

#ifndef ENMASK
#define ENMASK 0xff
#endif
#define EN(i) ((ENMASK >> (i)) & 1)
#ifndef REPMASK
#define REPMASK 0
#endif
#define REP(i) ((REPMASK >> (i)) & 1)
enum { PH_PRO = 0, PH_N0, PH_GQKV, PH_ATT, PH_OP, PH_F1, PH_F2, PH_FIN };
constexpr int NPHASES = 2 + 15 + 5 + 5 + 15 + 1;

__global__ void __launch_bounds__(NTHR, 2) mk_fwd(Args a) {
    extern __shared__ __attribute__((aligned(16))) unsigned char lds_raw[];
    ldsp lds0 = (ldsp)lds_raw;
    volatile LAS unsigned* bst = (volatile LAS unsigned*)(lds0 + LDS_BARST);
    if (threadIdx.x < 16) bst[threadIdx.x] = 0u;
    __syncthreads();
    XcdBarrier xbar = xcd_barrier_post((unsigned*)KWS(), bst);
#define WSP(T, off) ((T*)(KWS() + (off)))
    const int plo = (int)(((kargp)__builtin_amdgcn_kernarg_segment_ptr())[20] & 0xffffffffull), phi = (int)(((kargp)__builtin_amdgcn_kernarg_segment_ptr())[20] >> 32);
    for (int p = plo; p < phi; ++p) {
        int kind, layer = 0, chunk = 0;
        if (p == 0) kind = PH_PRO; else if (p == 1) kind = PH_N0; else if (p == NPHASES - 1) kind = PH_FIN;
        else { int q = p - 2; if (q < 15) layer = 0; else if (q < 20) { layer = 1; q -= 15; } else if (q < 25) { layer = 2; q -= 20; } else { layer = 3; q -= 25; }
            if (layer == 0 || layer == 3) { if (q < 12) { chunk = q >> 1; kind = (q & 1) ? PH_ATT : PH_GQKV; } else kind = PH_OP + (q - 12); }
            else { kind = q == 0 ? PH_GQKV : (q == 1 ? PH_ATT : PH_OP + (q - 2)); } }
        const int mk = layer % 3, mj = layer / 3;
        const float* xcur = (layer == 0 && kind == PH_OP) ? KIN(0) : KOUT();
        const float* modl = WSP(const float, WS_MOD) + (size_t)layer * 8 * 6144;
        const int nrep = 1 + ((kind == PH_PRO && REP(0)) || (kind == PH_N0 && REP(1)) || (kind == PH_GQKV && REP(2)) || (kind == PH_ATT && mk == 0 && REP(3)) || (kind == PH_ATT && mk == 1 && REP(4)) ||
                              (kind == PH_ATT && mk == 2 && REP(5)) || (kind == PH_F1 && REP(7)) || ((kind == PH_OP || kind == PH_F2) && REP(6)) ? 1 : 0);
        for (int rep = 0; rep < nrep; ++rep) {
        int tid = threadIdx.x; asm volatile("" : "+v"(tid));
        int G = gridDim.x, bid = blockIdx.x; unsigned lo_ = 0; asm volatile("" : "+s"(G), "+s"(bid), "+s"(lo_));
        ldsp lds = lds0 + lo_;
        const int lane = tid & 63, wave = __builtin_amdgcn_readfirstlane(tid >> 6);
        if (kind == PH_PRO && EN(0)) prologue(lds, tid, wave, lane, G, bid);
        else if (kind == PH_N0 && EN(1)) norm0_phase(tid, wave, lane, G, bid);
        else if (kind == PH_FIN && EN(1)) fin_phase(wave, lane, G, bid);
        else if (kind == PH_GQKV && EN(2)) {
            const int N = mk == 0 ? NG_IN : (mk == 1 ? NB_IN : NC_IN), M = mk == 0 ? MTOK / 2 : MTOK, grp = chunk >> 1, roff = mk == 0 ? (chunk & 1) * (MTOK / 2) : 0;
            const bf16* wt = WSP(bf16, WS_W) + (mk == 0 ? W_AIN + (size_t)mj * NA_IN * DM + (size_t)grp * NG_IN * DM : (mk == 1 ? W_BIN : W_CIN));
            pg8::Gemm g{WSP(bf16, WS_XN) + (size_t)roff * DM, wt, M, N, DM}; pg8::StaticOrder S; S.init(M, N, G, bid);
            pg8::EpiStoreBf16 E{WSP(bf16, WS_BIG), N, WSP(const float, WS_SS) + (size_t)(2 * layer) * MTOK, WSP(const float, WS_BIAS) + (size_t)(2 * layer) * 8 * BIAS_LD + (mk == 0 ? grp * NG_IN : 0), roff};
            pg8::gemm_phase<pg8::EpiStoreBf16, pg8::StaticOrder, true, true>(lds, g, S, E);
        }
        else if (kind == PH_ATT) {
            if (mk == 0 && EN(3)) attnA_phase(WSP(bf16, WS_BIG), WSP(bf16, WS_AO), WSP(float, WS_LSE), WSP(const float, WS_LUT), chunk >> 1, chunk & 1, lds, tid, wave, lane, G, bid);
            else if (mk == 1 && EN(4)) attnB_phase(WSP(bf16, WS_BIG), WSP(bf16, WS_AO), KIN(12), lds, tid, wave, lane, G, bid);
            else if (EN(5)) attnC_phase(WSP(bf16, WS_BIG), WSP(bf16, WS_AO), WSP(const float, WS_LUT) + LUTC_OFF, KIN(15), lds, tid, wave, lane, G, bid);
        }
        else if ((kind == PH_OP || kind == PH_F2) && EN(6)) {
            const bool op = kind == PH_OP;
            const bf16* wt = WSP(bf16, WS_W) + (op ? (mk == 0 ? W_AOUT + (size_t)mj * DM * DM : (mk == 1 ? W_BOUT : W_COUT)) : W_F2 + (size_t)layer * DM * DFF);
            pg8::Gemm g{op ? WSP(bf16, WS_AO) : WSP(bf16, WS_BIG), wt, MTOK, DM, op ? DM : DFF}; pg8::StaticOrder S; S.init(MTOK, DM, G, bid);
            const int nidx = 2 * layer + (op ? 1 : 2);
            const bool dummy = REP(6) && rep == 0;
            pg8::EpiResid E{xcur, dummy ? (op ? WSP(float, WS_BIG) : WSP(float, WS_XN)) : KOUT(), modl + (op ? 2048 : 5120), WSP(const float, WS_WV) + (size_t)nidx * 8 * 1024, (nidx == 8 || dummy) ? (bf16*)nullptr : WSP(bf16, WS_XN), WSP(float, WS_SS) + (size_t)(dummy ? 12 : nidx) * MTOK};
            pg8::gemm_phase<pg8::EpiResid, pg8::StaticOrder, true, true>(lds, g, S, E);
        }
        else if (kind == PH_F1 && EN(7)) {
            pg8::Gemm g{WSP(bf16, WS_XN), WSP(bf16, WS_W) + W_F1 + (size_t)layer * NFF2 * DM, MTOK, NFF2, DM}; pg8::StaticOrder S; S.init(MTOK, NFF2, G, bid);
            pg8::EpiSwiglu E{WSP(bf16, WS_BIG), DFF, WSP(const float, WS_SS) + (size_t)(2 * layer + 1) * MTOK, WSP(const float, WS_BIAS) + (size_t)(2 * layer + 1) * 8 * BIAS_LD};
            pg8::gemm_phase<pg8::EpiSwiglu, pg8::StaticOrder, true, true>(lds, g, S, E);
        }
        }
        if (p + 1 < phi) { if (p == plo) cg::this_grid().sync(); else xcd_barrier(xbar); }
    }
}

extern "C" void kernel_launch(void* const* d_in, const int* in_sizes, int n_in, void* d_out, int out_size, void* d_ws, size_t ws_size, hipStream_t stream) {
    static int grid = 0;
    if (grid == 0) {
        if (n_in != 18 || in_sizes[0] != MTOK * DM || out_size != MTOK * DM || ws_size < WS_END) { fprintf(stderr, "kernel_launch: unexpected shapes / workspace (n_in %d, ws %zu)\n", n_in, ws_size); grid = -1; return; }
        int dev = 0, cus = 0, per_cu = 0;
        (void)hipGetDevice(&dev); (void)hipDeviceGetAttribute(&cus, hipDeviceAttributeMultiprocessorCount, dev);
        if (hipFuncSetAttribute((const void*)mk_fwd, hipFuncAttributeMaxDynamicSharedMemorySize, LDS_BYTES) != hipSuccess) { fprintf(stderr, "kernel_launch: hipFuncSetAttribute failed\n"); grid = -1; return; }
        if (hipOccupancyMaxActiveBlocksPerMultiprocessor(&per_cu, (const void*)mk_fwd, NTHR, LDS_BYTES) != hipSuccess || per_cu < 1) { fprintf(stderr, "kernel_launch: occupancy query says %d\n", per_cu); per_cu = 1; }
        (void)hipGetLastError();
        grid = cus * per_cu;
        fprintf(stderr, "kernel_launch: grid %d (cus %d x %d)\n", grid, cus, per_cu);
    }
    if (grid < 0) return;
    if (hipMemsetAsync(d_ws, 0, 65536, stream) != hipSuccess || hipMemsetAsync((char*)d_ws + WS_SS, 0, 2 * MiB, stream) != hipSuccess) { fprintf(stderr, "kernel_launch: memset failed\n"); return; }
    Args a{};
    for (int i = 0; i < 18; ++i) a.in[i] = (const float*)d_in[i];
    a.out = (float*)d_out; a.ws = (unsigned char*)d_ws;
#if MK_PER_PHASE_LAUNCH
    for (int p = 0; p < NPHASES; ++p) { a.lo = p; a.hi = p + 1; hipLaunchKernelGGL(mk_fwd, dim3(grid), dim3(NTHR), LDS_BYTES, stream, a); }
#else
    a.lo = 0; a.hi = NPHASES;
    void* args[] = {&a};
    hipError_t e = hipLaunchCooperativeKernel((const void*)mk_fwd, dim3(grid), dim3(NTHR), args, LDS_BYTES, stream);
    if (e != hipSuccess) fprintf(stderr, "cooperative launch failed: %s (grid %d)\n", hipGetErrorString(e), grid);
#endif
}
```
